# Optimizing an MI355X kernel written in HIP

```python
import math
import jax
import jax.numpy as jnp
from jax import lax
import numpy as np

D_MODEL = 2048
BATCH = 1
SEQ = 16384
DEPTH = 4
DEC_BATCH = 2
DEC_SEQ = 8192
PAST_LEN = 128

HEAD_DIM = 128
A_Q_HEADS = 8
A_KV_HEADS = 2
B_Q_HEADS = 8
B_KV_HEADS = 2
A_WIDTH = A_Q_HEADS * HEAD_DIM
B_WIDTH = B_Q_HEADS * HEAD_DIM
MIX_WIDTH = A_WIDTH + B_WIDTH
A_KV_WIDTH = A_KV_HEADS * HEAD_DIM
B_KV_WIDTH = B_KV_HEADS * HEAD_DIM
IN_WIDTH = A_WIDTH + 2 * A_KV_WIDTH + B_WIDTH + 2 * B_KV_WIDTH
SPLITS = (A_WIDTH, A_WIDTH + A_KV_WIDTH, A_WIDTH + 2 * A_KV_WIDTH,
          A_WIDTH + 2 * A_KV_WIDTH + B_WIDTH, A_WIDTH + 2 * A_KV_WIDTH + B_WIDTH + B_KV_WIDTH)
D_FF = 4 * D_MODEL
Q_BLOCK = 128
WINDOW = 128
NUM_BUCKETS = 32
MAX_DISTANCE = 128
GRID_W = 64
ROPE_THETA = 10000.0
EPS = 1e-6

kernel_name = 'hymba_axial_window_sink_encoder'


def rms_norm(x, g):
    xf = x.astype(jnp.float32)
    y = xf * lax.rsqrt(jnp.mean(xf * xf, axis=-1, keepdims=True) + EPS)
    return (y * g.astype(jnp.float32)).astype(x.dtype)


def axial_rope_tables(t_len):
    rows = t_len // GRID_W
    row_ids = jnp.repeat(jnp.arange(rows, dtype=jnp.float32), GRID_W)
    col_ids = jnp.tile(jnp.arange(GRID_W, dtype=jnp.float32), rows)
    half = HEAD_DIM // 2
    inv_freq = ROPE_THETA ** (-jnp.arange(0, half, 2, dtype=jnp.float32) / half)
    ang_r = row_ids[:, None] * inv_freq[None, :]
    ang_c = col_ids[:, None] * inv_freq[None, :]
    ang = jnp.concatenate([ang_r, ang_r, ang_c, ang_c], axis=-1)
    return jnp.cos(ang), jnp.sin(ang)


def apply_axial_rope(x, cos, sin):
    xf = x.astype(jnp.float32)
    x1, x2, x3, x4 = jnp.split(xf, 4, axis=-1)
    rot = jnp.concatenate([-x2, x1, -x4, x3], axis=-1)
    return (xf * cos[None, :, None, :] + rot * sin[None, :, None, :]).astype(x.dtype)


def t5_bucket(rel):
    half = NUM_BUCKETS // 2
    max_exact = half // 2
    n = jnp.abs(rel)
    nf = jnp.maximum(n, 1).astype(jnp.float32)
    large = max_exact + (jnp.log(nf / max_exact) / math.log(MAX_DISTANCE / max_exact)
                         * (half - max_exact)).astype(jnp.int32)
    large = jnp.minimum(large, half - 1)
    return jnp.where(rel > 0, half, 0) + jnp.where(n < max_exact, n, large)


def band_bias(rel_bias):
    kw = Q_BLOCK + 2 * WINDOW
    rel = jnp.arange(kw)[None, :] - WINDOW - jnp.arange(Q_BLOCK)[:, None]
    bias = rel_bias[t5_bucket(rel)].astype(jnp.float32)
    g = B_Q_HEADS // B_KV_HEADS
    return bias.transpose(2, 0, 1).reshape(B_KV_HEADS, g, Q_BLOCK, kw), jnp.abs(rel) <= WINDOW


def global_gqa(q, k, v):
    b, t = q.shape[0], q.shape[1]
    nb = t // Q_BLOCK
    g = A_Q_HEADS // A_KV_HEADS
    qb = q.reshape(b, nb, Q_BLOCK, A_KV_HEADS, g, HEAD_DIM).transpose(1, 0, 2, 3, 4, 5)
    scale = HEAD_DIM ** -0.5

    def block(qi):
        s = jnp.einsum('bqhgd,bkhd->bhgqk', qi, k, preferred_element_type=jnp.float32) * scale
        p = jax.nn.softmax(s, axis=-1).astype(v.dtype)
        return jnp.einsum('bhgqk,bkhd->bqhgd', p, v)

    o = lax.map(block, qb)
    return o.transpose(1, 0, 2, 3, 4, 5).reshape(b, t, A_WIDTH)


def windowed_gqa_sink(q, k, v, bias, band_ok, sink):
    b, t = q.shape[0], q.shape[1]
    nb = t // Q_BLOCK
    g = B_Q_HEADS // B_KV_HEADS
    kw = Q_BLOCK + 2 * WINDOW
    n_shift = kw // Q_BLOCK
    qb = q.reshape(b, nb, Q_BLOCK, B_KV_HEADS, g, HEAD_DIM)

    def band(z):
        zp = jnp.pad(z, ((0, 0), (WINDOW, WINDOW), (0, 0), (0, 0)))
        zp = zp.reshape(b, nb + n_shift - 1, Q_BLOCK, B_KV_HEADS, HEAD_DIM)
        return jnp.concatenate([zp[:, i:i + nb] for i in range(n_shift)], axis=2)

    kb, vb = band(k), band(v)
    kpos = jnp.arange(nb)[:, None] * Q_BLOCK - WINDOW + jnp.arange(kw)[None, :]
    key_ok = (kpos >= 0) & (kpos < t)
    mask = band_ok[None, :, :] & key_ok[:, None, :]
    s = jnp.einsum('bnqhgd,bnkhd->bnhgqk', qb, kb, preferred_element_type=jnp.float32) * (HEAD_DIM ** -0.5)
    s = jnp.where(mask[None, :, None, None], s + bias[None, None], -jnp.inf)
    sk = sink.astype(jnp.float32).reshape(B_KV_HEADS, g)[None, None, :, :, None, None]
    m = jnp.maximum(jnp.max(s, axis=-1, keepdims=True), sk)
    e = jnp.exp(s - m)
    p = e / (jnp.sum(e, axis=-1, keepdims=True) + jnp.exp(sk - m))
    o = jnp.einsum('bnhgqk,bnkhd->bnqhgd', p.astype(v.dtype), vb)
    return o.reshape(b, t, B_WIDTH)


def encoder_layer(x, c, cos, sin, bias, band_ok, w_mod, b_mod, norm_attn, w_in, q_norm, k_norm,
                  sink, out_norm_a, out_norm_b, w_out, norm_mlp, w_up, w_down):
    b, t = x.shape[0], x.shape[1]
    mod = jnp.einsum('bd,de->be', jax.nn.silu(c), w_mod) + b_mod
    sh1, sc1, gt1, sh2, sc2, gt2 = jnp.split(mod[:, None, :], 6, axis=-1)

    h = rms_norm(x, norm_attn) * (1 + sc1) + sh1
    proj = jnp.einsum('btd,de->bte', h, w_in)
    qa, ka, va, qb, kb, vb = jnp.split(proj, SPLITS, axis=-1)
    qa = apply_axial_rope(rms_norm(qa.reshape(b, t, A_Q_HEADS, HEAD_DIM), q_norm), cos, sin)
    ka = apply_axial_rope(rms_norm(ka.reshape(b, t, A_KV_HEADS, HEAD_DIM), k_norm), cos, sin)
    va = va.reshape(b, t, A_KV_HEADS, HEAD_DIM)
    out_a = global_gqa(qa, ka, va)
    out_b = windowed_gqa_sink(qb.reshape(b, t, B_Q_HEADS, HEAD_DIM),
                              kb.reshape(b, t, B_KV_HEADS, HEAD_DIM),
                              vb.reshape(b, t, B_KV_HEADS, HEAD_DIM), bias, band_ok, sink)
    mix = jnp.concatenate([rms_norm(out_a, out_norm_a), rms_norm(out_b, out_norm_b)], axis=-1)
    x = x + gt1 * jnp.einsum('bte,ed->btd', mix, w_out)

    h = rms_norm(x, norm_mlp) * (1 + sc2) + sh2
    u = jax.nn.relu(jnp.einsum('btd,df->btf', h, w_up))
    x = x + gt2 * jnp.einsum('btf,fd->btd', u * u, w_down)
    return x


def run_trunk(x, c, w_mod, b_mod, norm_attn, w_in, q_norm, k_norm, sink, out_norm_a, out_norm_b,
              w_out, norm_mlp, w_up, w_down, rel_bias, norm_final):
    cos, sin = axial_rope_tables(x.shape[1])
    bias, band_ok = band_bias(rel_bias)
    for l in range(DEPTH):
        x = encoder_layer(x, c, cos, sin, bias, band_ok, w_mod[l], b_mod[l], norm_attn[l], w_in[l],
                          q_norm[l], k_norm[l], sink[l], out_norm_a[l], out_norm_b[l], w_out[l],
                          norm_mlp[l], w_up[l], w_down[l])
    return rms_norm(x, norm_final)


def setup_inputs(seed: int = 0) -> dict:
    key = jax.random.key(seed)
    ks = jax.random.split(key, 20)

    def nrm(k, shape, s):
        return jax.random.normal(k, shape, jnp.float32) * s

    return {
        'x_prompt': nrm(ks[0], (BATCH, SEQ, D_MODEL), 1.0),
        'x_sample': nrm(ks[1], (DEC_BATCH, DEC_SEQ, D_MODEL), 1.0),
        'c_prompt': nrm(ks[2], (BATCH, D_MODEL), 1.0),
        'c_sample': nrm(ks[3], (DEC_BATCH, D_MODEL), 1.0),
        'w_mod': nrm(ks[4], (DEPTH, D_MODEL, 6 * D_MODEL), D_MODEL ** -0.5),
        'b_mod': nrm(ks[5], (DEPTH, 6 * D_MODEL), 0.02),
        'norm_attn': 1.0 + nrm(ks[6], (DEPTH, D_MODEL), 0.02),
        'w_in': nrm(ks[7], (DEPTH, D_MODEL, IN_WIDTH), D_MODEL ** -0.5),
        'q_norm': 1.0 + nrm(ks[8], (DEPTH, HEAD_DIM), 0.02),
        'k_norm': 1.0 + nrm(ks[9], (DEPTH, HEAD_DIM), 0.02),
        'sink': nrm(ks[10], (DEPTH, B_Q_HEADS), 0.5),
        'out_norm_a': 1.0 + nrm(ks[11], (DEPTH, A_WIDTH), 0.02),
        'out_norm_b': 1.0 + nrm(ks[12], (DEPTH, B_WIDTH), 0.02),
        'w_out': nrm(ks[13], (DEPTH, MIX_WIDTH, D_MODEL), MIX_WIDTH ** -0.5),
        'norm_mlp': 1.0 + nrm(ks[14], (DEPTH, D_MODEL), 0.02),
        'w_up': nrm(ks[15], (DEPTH, D_MODEL, D_FF), D_MODEL ** -0.5),
        'w_down': nrm(ks[16], (DEPTH, D_FF, D_MODEL), D_FF ** -0.5),
        'rel_bias': nrm(ks[17], (NUM_BUCKETS, B_Q_HEADS), 0.5),
        'norm_final': 1.0 + nrm(ks[18], (D_MODEL,), 0.02),
    }


def reference(x_prompt, x_sample, c_prompt, c_sample, w_mod, b_mod, norm_attn, w_in, q_norm, k_norm,
              sink, out_norm_a, out_norm_b, w_out, norm_mlp, w_up, w_down, rel_bias, norm_final):
    y_prompt = run_trunk(x_prompt, c_prompt, w_mod, b_mod, norm_attn, w_in, q_norm, k_norm, sink,
                         out_norm_a, out_norm_b, w_out, norm_mlp, w_up, w_down, rel_bias, norm_final)
    y_sample = run_trunk(x_sample, c_sample, w_mod, b_mod, norm_attn, w_in, q_norm, k_norm, sink,
                         out_norm_a, out_norm_b, w_out, norm_mlp, w_up, w_down, rel_bias, norm_final)
    return (y_prompt, y_sample)
```

```cpp
#include <hip/hip_runtime.h>
#include <hip/hip_bf16.h>
#include <cstdio>
#include <cstdint>
namespace pg8 {
#define PG8_LAS __attribute__((address_space(3)))
typedef unsigned short bf16_t;
typedef short bf16x8 __attribute__((ext_vector_type(8)));
typedef float f32x4 __attribute__((ext_vector_type(4)));
typedef unsigned u32x4 __attribute__((ext_vector_type(4)));
constexpr int BM = 256, BK = 64, HALF = 128, HTB = HALF * BK * 2  , STAGE_BYTES = 8 * HTB, NXCD = 8, WGM = 8;

__host__ __device__ __forceinline__ int lds_byte(int r, int c) { const int st = (r >> 4) * 2 + (c >> 5), rr = r & 15, cc = c & 31, ob = rr * 64 + cc * 2; return st * 1024 + (ob ^ (((ob >> 9) & 1) << 5)); }
__host__ __device__ __forceinline__ void stage_rc(int b, int& R, int& C) { const int st = b / 1024, sb = b % 1024, swz = sb ^ (((sb >> 9) & 1) << 5); R = (st >> 1) * 16 + swz / 64; C = (st & 1) * 32 + (swz % 64) / 2; }
__host__ __device__ __forceinline__ int perm32(int rho) { const int n = rho >> 4, i = rho & 15; return 8 * (i >> 2) + 4 * n + (i & 3); }

struct Unit { int pm, pn; };
struct Gemm { const bf16_t* A; const bf16_t* Bt; int M, N, K; };

struct StaticOrder {
    int nM, nN, nwg, G, c;
    __host__ __device__ void init(int M, int N, int G_, int c_) { nM = M / BM; nN = N / BM; nwg = nM * nN; G = G_; c = c_; }
    __host__ __device__ bool next(int i, Unit& u) const {
        const long L = (long)i * G + c; if (L >= nwg) return false;
        int wgid = (int)L; { const int q = nwg / NXCD, r = nwg % NXCD, xcd = wgid % NXCD, off = wgid / NXCD; wgid = (xcd < r ? xcd * (q + 1) : r * (q + 1) + (xcd - r) * q) + off; }
        const int nig = WGM * nN, gid = wgid / nig, fm = gid * WGM, gsz = (nM - fm) < WGM ? (nM - fm) : WGM;
        u.pm = fm + ((wgid % nig) % gsz); u.pn = (wgid % nig) / gsz; return true;
    }
    __device__ __forceinline__ void a_ready(const Unit&) const {}
    __device__ __forceinline__ void done(const Unit&) const {}
};

__device__ __forceinline__ unsigned cvt_pk_bf16(float lo, float hi) { unsigned r; asm volatile("v_cvt_pk_bf16_f32 %0, %1, %2" : "=v"(r) : "v"(lo), "v"(hi)); return r; }
typedef float f32x2 __attribute__((ext_vector_type(2)));
struct EpiBf16 {
    static constexpr bool PERM = true, AFTER_DRAIN = false;
    bf16_t* O; int ldc; int act;
    __device__ __forceinline__ void operator()(const f32x4 (&acc)[2][2][4][2], const Unit& u, int wr, int wc, int fr, int fq) const {
        const int row0 = u.pm * BM + wr * 64 + fr; const int col0 = u.pn * BM + wc * 32 + 8 * fq;
#pragma unroll
        for (int ai = 0; ai < 2; ++ai)
#pragma unroll
            for (int m = 0; m < 4; ++m) { bf16_t* rowp = O + (size_t)(row0 + ai * HALF + m * 16) * ldc + col0;
#pragma unroll
                for (int bj = 0; bj < 2; ++bj) { f32x4 v0 = acc[ai][bj][m][0], v1 = acc[ai][bj][m][1];
                    if (act) {
#pragma unroll
                        for (int j = 0; j < 4; ++j) { const float a = fmaxf(v0[j], 0.f), b = fmaxf(v1[j], 0.f); v0[j] = a * a; v1[j] = b * b; } }
                    u32x4 w; w.x = cvt_pk_bf16(v0[0], v0[1]); w.y = cvt_pk_bf16(v0[2], v0[3]); w.z = cvt_pk_bf16(v1[0], v1[1]); w.w = cvt_pk_bf16(v1[2], v1[3]);
                    *(u32x4*)(rowp + bj * HALF) = w; } }
    }
};
struct EpiRes {
    static constexpr bool PERM = false, AFTER_DRAIN = false;
    const float* base0; const float* base1; float* out; const float* gate;
    __device__ __forceinline__ void operator()(const f32x4 (&acc)[2][2][4][2], const Unit& u, int wr, int wc, int fr, int fq) const {
        const int row0 = u.pm * BM + wr * 64 + fr, col0 = u.pn * BM + wc * 32 + 4 * fq;
        const int s = u.pm < 64 ? 0 : (u.pm < 96 ? 1 : 2);
        const float* g = gate + s * 12288 + col0;
        const float* bp = u.pm < 64 ? base0 + (size_t)row0 * 2048 + col0 : base1 + (size_t)(row0 - 16384) * 2048 + col0;
        float* op = out + (size_t)row0 * 2048 + col0;
        f32x4 gv[2][2];
#pragma unroll
        for (int bj = 0; bj < 2; ++bj)
#pragma unroll
            for (int n = 0; n < 2; ++n) gv[bj][n] = *(const f32x4*)(g + bj * HALF + n * 16);
#pragma unroll
        for (int ai = 0; ai < 2; ++ai)
#pragma unroll
            for (int m = 0; m < 4; ++m) { const size_t ro = (size_t)(ai * HALF + m * 16) * 2048;
#pragma unroll
                for (int bj = 0; bj < 2; ++bj)
#pragma unroll
                    for (int n = 0; n < 2; ++n) { const f32x4 b = *(const f32x4*)(bp + ro + bj * HALF + n * 16);
                        *(f32x4*)(op + ro + bj * HALF + n * 16) = b + gv[bj][n] * acc[ai][bj][m][n]; } }
    }
};
template <class Epi, class Sched, bool ALIGN_EPI = false, bool SP2 = false>
__device__ __forceinline__ void gemm_phase(PG8_LAS unsigned char* lds, const Gemm g, const Sched& S, const Epi& E) {
    int tid_ = threadIdx.x; asm volatile("" : "+v"(tid_));
    const int tid = tid_, wid = __builtin_amdgcn_readfirstlane(tid >> 6), lane = tid & 63, wr = wid >> 2, wc = wid & 3, fr = lane & 15, fq = lane >> 4;
    const int K = g.K, nt = K / BK;
    unsigned voffA[2], voffB[2];
#pragma unroll
    for (int i = 0; i < 2; ++i) { int R, C; stage_rc(tid * 16 + i * 8192, R, C); const int Rb = Epi::PERM ? ((R & ~31) + perm32(R & 31)) : R;
        voffA[i] = (unsigned)(R * K + C) * 2u; voffB[i] = (unsigned)(Rb * K + C) * 2u; }
    const size_t kstep = (size_t)(BK * 2);
    const size_t hstep = (size_t)HALF * K * 2;
    const size_t tstep = 2 * hstep;
    const unsigned ldsw = (unsigned)wid * 1024u;
    const int aoff = lds_byte(wr * 64 + fr, fq * 8), boff = lds_byte(wc * 32 + fr, fq * 8);
#define PG8_SA(b, h) (((b) * 2 + (h)) * HTB)
#define PG8_SB(b, h) ((4 + (b) * 2 + (h)) * HTB)
#define PG8_STAGE(bufoff, gbase, voff) do { _Pragma("unroll") for (int _i = 0; _i < 2; ++_i) \
        __builtin_amdgcn_global_load_lds((const unsigned*)((const char*)(gbase) + (voff)[_i]), (PG8_LAS unsigned*)(lds + (bufoff) + ldsw + _i * 8192), 16, 0, 0); } while (0)
#define PG8_LDA(dst, b, h) do { _Pragma("unroll") for (int m = 0; m < 4; ++m) _Pragma("unroll") for (int k = 0; k < 2; ++k) dst[m][k] = *(const PG8_LAS bf16x8*)(lds + PG8_SA(b, h) + aoff + m * 2048 + k * 1024); } while (0)
#define PG8_LDB(dst, b, h) do { _Pragma("unroll") for (int n = 0; n < 2; ++n) _Pragma("unroll") for (int k = 0; k < 2; ++k) dst[n][k] = *(const PG8_LAS bf16x8*)(lds + PG8_SB(b, h) + boff + n * 2048 + k * 1024); } while (0)
#define PG8_MMA(ai, bj, At, Bt) do { __builtin_amdgcn_s_setprio(1); _Pragma("unroll") for (int m = 0; m < 4; ++m) _Pragma("unroll") for (int n = 0; n < 2; ++n) _Pragma("unroll") for (int k = 0; k < 2; ++k) \
        acc[ai][bj][m][n] = __builtin_amdgcn_mfma_f32_16x16x32_bf16(Bt[n][k], At[m][k], acc[ai][bj][m][n], 0, 0, 0); __builtin_amdgcn_s_setprio(0); } while (0)
#define PG8_WAIT_V(n) asm volatile("s_waitcnt vmcnt(" #n ")" ::: "memory")
#define PG8_WAIT_L(n) asm volatile("s_waitcnt lgkmcnt(" #n ")" ::: "memory")
#define PG8_BAR __builtin_amdgcn_s_barrier()
#define PG8_SCHED __builtin_amdgcn_sched_barrier(0)
    Unit cur, nxt; int ui = 0;
    if (!S.next(0, cur)) return;
    f32x4 acc[2][2][4][2];
#pragma unroll
    for (int a = 0; a < 2; ++a)
#pragma unroll
        for (int b = 0; b < 2; ++b)
#pragma unroll
            for (int m = 0; m < 4; ++m)
#pragma unroll
                for (int n = 0; n < 2; ++n) acc[a][b][m][n] = (f32x4){0.f, 0.f, 0.f, 0.f};
    bf16x8 At[4][2], B0[2][2], B1[2][2];
    const char* cA = (const char*)g.A + (size_t)cur.pm * tstep; const char* cB = (const char*)g.Bt + (size_t)cur.pn * tstep;
    S.a_ready(cur);
    if constexpr (SP2) {
        PG8_STAGE(PG8_SB(0, 0), cB, voffB); PG8_STAGE(PG8_SB(0, 1), cB + hstep, voffB); PG8_STAGE(PG8_SA(0, 0), cA, voffA); PG8_STAGE(PG8_SA(0, 1), cA + hstep, voffA);
        if (wr == 1) PG8_BAR;
        PG8_WAIT_V(2); PG8_BAR;
        PG8_STAGE(PG8_SB(1, 0), cB + kstep, voffB); PG8_STAGE(PG8_SA(1, 0), cA + kstep, voffA); PG8_STAGE(PG8_SB(1, 1), cB + hstep + kstep, voffB);
        PG8_WAIT_V(6); PG8_BAR;
    } else {
        PG8_STAGE(PG8_SB(0, 0), cB, voffB); PG8_STAGE(PG8_SA(0, 0), cA, voffA); PG8_STAGE(PG8_SB(0, 1), cB + hstep, voffB); PG8_STAGE(PG8_SA(0, 1), cA + hstep, voffA);
        if (wr == 1) PG8_BAR;
        PG8_WAIT_V(4); PG8_BAR;
        PG8_STAGE(PG8_SB(1, 0), cB + kstep, voffB); PG8_STAGE(PG8_SA(1, 0), cA + kstep, voffA); PG8_STAGE(PG8_SB(1, 1), cB + hstep + kstep, voffB);
        PG8_WAIT_V(6); PG8_BAR;
    }
    for (;;) {
        const bool has_next = S.next(ui + 1, nxt);
        const char* nA = has_next ? (const char*)g.A + (size_t)nxt.pm * tstep : cA; const char* nB = has_next ? (const char*)g.Bt + (size_t)nxt.pn * tstep : cB;
        for (int t = 0; t < nt; t += 2) {
            const bool last = (t == nt - 2);
            const char* a1 = cA + (size_t)(t + 1) * kstep;
            const char* a2 = last ? nA : cA + (size_t)(t + 2) * kstep; const char* b2 = last ? nB : cB + (size_t)(t + 2) * kstep;
            const char* a3 = a2 + kstep; const char* b3 = b2 + kstep;
            if (last && has_next) S.a_ready(nxt);
            if constexpr (SP2) {
            PG8_LDB(B0, 0, 0); PG8_LDB(B1, 0, 1); PG8_SCHED; PG8_LDA(At, 0, 0); PG8_STAGE(PG8_SA(1, 1), a1 + hstep, voffA);
            PG8_WAIT_V(8); PG8_WAIT_L(0); PG8_BAR; PG8_MMA(0, 0, At, B0); PG8_MMA(0, 1, At, B1); PG8_BAR; PG8_SCHED;
            PG8_LDA(At, 0, 1); PG8_STAGE(PG8_SB(0, 0), b2, voffB); PG8_STAGE(PG8_SB(0, 1), b2 + hstep, voffB); PG8_STAGE(PG8_SA(0, 0), a2, voffA);
            PG8_WAIT_V(8); PG8_WAIT_L(0); PG8_BAR; PG8_MMA(1, 0, At, B0); PG8_MMA(1, 1, At, B1); PG8_BAR; PG8_SCHED;
            PG8_LDB(B0, 1, 0); PG8_LDB(B1, 1, 1); PG8_SCHED; PG8_LDA(At, 1, 0); PG8_STAGE(PG8_SA(0, 1), a2 + hstep, voffA);
            PG8_WAIT_V(8); PG8_WAIT_L(0); PG8_BAR; PG8_MMA(0, 0, At, B0); PG8_MMA(0, 1, At, B1); PG8_BAR; PG8_SCHED;
            PG8_LDA(At, 1, 1); PG8_STAGE(PG8_SB(1, 0), b3, voffB); PG8_STAGE(PG8_SB(1, 1), b3 + hstep, voffB); PG8_STAGE(PG8_SA(1, 0), a3, voffA);
            PG8_WAIT_V(8); PG8_WAIT_L(0); PG8_BAR; PG8_MMA(1, 0, At, B0); PG8_MMA(1, 1, At, B1); PG8_BAR; PG8_SCHED;
            } else {
            PG8_LDB(B0, 0, 0); PG8_SCHED; PG8_LDA(At, 0, 0); PG8_STAGE(PG8_SA(1, 1), a1 + hstep, voffA);
            PG8_WAIT_L(8); PG8_BAR; PG8_WAIT_L(0); PG8_MMA(0, 0, At, B0); PG8_BAR; PG8_SCHED;
            PG8_LDB(B1, 0, 1); PG8_STAGE(PG8_SB(0, 0), b2, voffB);
            PG8_BAR; PG8_WAIT_L(0); PG8_MMA(0, 1, At, B1); PG8_BAR;
            PG8_LDA(At, 0, 1); PG8_STAGE(PG8_SA(0, 0), a2, voffA);
            PG8_BAR; PG8_WAIT_L(0); PG8_MMA(1, 0, At, B0); PG8_BAR; PG8_SCHED;
            PG8_STAGE(PG8_SB(0, 1), b2 + hstep, voffB);
            PG8_WAIT_V(6); PG8_BAR; PG8_MMA(1, 1, At, B1); PG8_BAR;
            PG8_LDB(B0, 1, 0); PG8_SCHED; PG8_LDA(At, 1, 0); PG8_STAGE(PG8_SA(0, 1), a2 + hstep, voffA);
            PG8_WAIT_L(8); PG8_BAR; PG8_WAIT_L(0); PG8_MMA(0, 0, At, B0); PG8_BAR; PG8_SCHED;
            PG8_LDB(B1, 1, 1); PG8_STAGE(PG8_SB(1, 0), b3, voffB);
            PG8_BAR; PG8_WAIT_L(0); PG8_MMA(0, 1, At, B1); PG8_BAR;
            PG8_LDA(At, 1, 1); PG8_STAGE(PG8_SA(1, 0), a3, voffA);
            PG8_BAR; PG8_WAIT_L(0); PG8_MMA(1, 0, At, B0); PG8_BAR; PG8_SCHED;
            PG8_STAGE(PG8_SB(1, 1), b3 + hstep, voffB);
            PG8_WAIT_V(6); PG8_BAR; PG8_MMA(1, 1, At, B1); PG8_BAR;
            }
        }
        if constexpr (ALIGN_EPI) { if (wr == 0) PG8_BAR; }
        if constexpr (!Epi::AFTER_DRAIN) { E(acc, cur, wr, wc, fr, fq); S.done(cur); }
        if (!has_next) break;
#pragma unroll
        for (int a = 0; a < 2; ++a)
#pragma unroll
            for (int b = 0; b < 2; ++b)
#pragma unroll
                for (int m = 0; m < 4; ++m)
#pragma unroll
                    for (int n = 0; n < 2; ++n) acc[a][b][m][n] = (f32x4){0.f, 0.f, 0.f, 0.f};
        cur = nxt; cA = nA; cB = nB; ++ui;
        if constexpr (ALIGN_EPI) { if (wr == 1) PG8_BAR; }
    }
    PG8_WAIT_V(0);
    if constexpr (!ALIGN_EPI) { if (wr == 0) PG8_BAR; }
    PG8_BAR;
    if constexpr (Epi::AFTER_DRAIN) { E.fused(acc, cur, wr, wc, fr, fq, lds, wid, lane); S.done(cur); }
#undef PG8_SA
#undef PG8_SB
#undef PG8_STAGE
#undef PG8_LDA
#undef PG8_LDB
#undef PG8_MMA
#undef PG8_WAIT_V
#undef PG8_WAIT_L
#undef PG8_BAR
#undef PG8_SCHED
}
}
namespace att {
using bf16 = __hip_bfloat16;
constexpr int   D = 128, NW = 8, QBLK = 32, KVBLK = 64;
constexpr float SCALE = 0.088388347648318440f;
constexpr float LOG2E = 1.4426950408889634f;
constexpr float THR = 8.f;
constexpr int LDQ = 3072, LDK = 3072, LDO = 2048;
constexpr size_t SHM_V = KVBLK * D * 2, SHM_K = KVBLK * D * 2, SHM_ATTN = 2 * SHM_V + 2 * SHM_K + NW * 64 * 4;

using bf16x8 = __attribute__((ext_vector_type(8))) short;
using s16x4  = __attribute__((ext_vector_type(4))) short;
using f32x16 = __attribute__((ext_vector_type(16))) float;
using u32x4  = __attribute__((ext_vector_type(4))) unsigned;
#define KSWZ(row, colB) ((row) * 256 + ((colB) ^ (((row) & 7) << 4)))
#define SBAR() __builtin_amdgcn_sched_barrier(0)
__device__ __forceinline__ int crow(int r, int hi) { return (r & 3) + 8 * (r >> 2) + 4 * hi; }
__device__ __forceinline__ unsigned cvtpk(float lo, float hi) { unsigned r; asm volatile("v_cvt_pk_bf16_f32 %0, %1, %2" : "=v"(r) : "v"(lo), "v"(hi)); return r; }
__device__ __forceinline__ bf16x8 ld8(const bf16* p) { return *reinterpret_cast<const bf16x8*>(p); }

__device__ __forceinline__ void partialSM(f32x16& p0, f32x16& p1, float& m_reg, float& mn, float& alpha) {
  constexpr float C = SCALE * LOG2E;
  float pmax = p0[0]; for (int r = 1; r < 16; ++r) pmax = fmaxf(pmax, p0[r]); for (int r = 0; r < 16; ++r) pmax = fmaxf(pmax, p1[r]);
  { auto rr = __builtin_amdgcn_permlane32_swap(__float_as_uint(pmax), __float_as_uint(pmax), false, false);
    pmax = fmaxf(__uint_as_float(rr[0]), __uint_as_float(rr[1])); }
  if (__builtin_expect(__all(pmax - m_reg <= THR / SCALE), 1)) { mn = m_reg; alpha = 1.f; }
  else { mn = fmaxf(m_reg, pmax); alpha = __builtin_amdgcn_exp2f((m_reg - mn) * C); m_reg = mn; }
  float mnC = -mn * C;
  for (int r = 0; r < 16; ++r) p0[r] = fmaf(p0[r], C, mnC); for (int r = 0; r < 16; ++r) p1[r] = fmaf(p1[r], C, mnC);
  for (int r = 0; r < 16; ++r) p0[r] = __builtin_amdgcn_exp2f(p0[r]);
}
__device__ __forceinline__ void partialSM_w(f32x16& p0, f32x16& p1, float& m_reg, float& mn, float& alpha) {
  float pmax = p0[0]; for (int r = 1; r < 16; ++r) pmax = fmaxf(pmax, p0[r]); for (int r = 0; r < 16; ++r) pmax = fmaxf(pmax, p1[r]);
  { auto rr = __builtin_amdgcn_permlane32_swap(__float_as_uint(pmax), __float_as_uint(pmax), false, false);
    pmax = fmaxf(__uint_as_float(rr[0]), __uint_as_float(rr[1])); }
  if (__builtin_expect(__all(pmax - m_reg <= THR * LOG2E), 1)) { mn = m_reg; alpha = 1.f; }
  else { mn = fmaxf(m_reg, pmax); alpha = __builtin_amdgcn_exp2f(m_reg - mn); m_reg = mn; }
  for (int r = 0; r < 16; ++r) p0[r] = p0[r] - mn; for (int r = 0; r < 16; ++r) p1[r] = p1[r] - mn;
  for (int r = 0; r < 16; ++r) p0[r] = __builtin_amdgcn_exp2f(p0[r]);
}
__device__ __forceinline__ void finishSM(f32x16& p0, f32x16& p1, float alpha, float& l_reg, bf16x8& pa0, bf16x8& pa1, bf16x8& pa2, bf16x8& pa3) {
  for (int r = 0; r < 16; ++r) p1[r] = __builtin_amdgcn_exp2f(p1[r]);
  float ps = 0; for (int r = 0; r < 16; ++r) ps += p0[r]; for (int r = 0; r < 16; ++r) ps += p1[r];
  { auto rr = __builtin_amdgcn_permlane32_swap(__float_as_uint(ps), __float_as_uint(ps), false, false);
    ps = __uint_as_float(rr[0]) + __uint_as_float(rr[1]); }
  l_reg = l_reg * alpha + ps;
#define PK4(P, BASE, OUT) do { unsigned a0 = cvtpk(P[BASE + 0], P[BASE + 1]), a1 = cvtpk(P[BASE + 2], P[BASE + 3]);   \
    unsigned b0 = cvtpk(P[BASE + 4], P[BASE + 5]), b1 = cvtpk(P[BASE + 6], P[BASE + 7]);                              \
    auto r0 = __builtin_amdgcn_permlane32_swap(a0, b0, false, false); auto r1 = __builtin_amdgcn_permlane32_swap(a1, b1, false, false); \
    u32x4 w = {r0[0], r1[0], r0[1], r1[1]}; OUT = *reinterpret_cast<bf16x8*>(&w); } while (0)
  PK4(p0, 0, pa0); PK4(p0, 8, pa1); PK4(p1, 0, pa2); PK4(p1, 8, pa3);
#undef PK4
}
__device__ __forceinline__ void qkt(f32x16& p0, f32x16& p1, const bf16* Ks, const bf16x8* qr, int r32, int hi) {
  p0 = f32x16{}; p1 = f32x16{};
  for (int d0 = 0; d0 < 8; ++d0) { int cb = (d0 * 16 + hi * 8) * 2;
    bf16x8 b0 = *reinterpret_cast<const bf16x8*>((const char*)Ks + KSWZ(r32, cb));
    bf16x8 b1 = *reinterpret_cast<const bf16x8*>((const char*)Ks + KSWZ(32 + r32, cb));
    p0 = __builtin_amdgcn_mfma_f32_32x32x16_bf16(b0, qr[d0], p0, 0, 0, 0);
    p1 = __builtin_amdgcn_mfma_f32_32x32x16_bf16(b1, qr[d0], p1, 0, 0, 0); }
}
__device__ __forceinline__ int v_st(int k, int c) { const int kk = (k & ~0xC) | ((k & 4) << 1) | ((k & 8) >> 1); return ((kk >> 3) * 4 + (c >> 5)) * 512 + ((kk & 7) * 32 + (c & 31)) * 2; }
__device__ __forceinline__ int v_rd_base(int lane) { return ((lane & 3) << 3) | (((lane >> 2) & 3) << 6) | (((lane >> 4) & 1) << 5) | (((lane >> 5) & 1) << 8); }
constexpr int v_rd_off(int d0, int ks, int half) { return d0 * 512 + ks * 4096 + half * 2048; }
template <int OFF> __device__ __forceinline__ s16x4 tr_read(int vb) {
  s16x4 r; asm volatile("ds_read_b64_tr_b16 %0, %1 offset:%2" : "=&v"(r) : "v"(vb), "i"(OFF) : "memory"); return r;
}
template <int D0> __device__ __forceinline__ void pv_one(f32x16& od, int vb, bf16x8 pa0, bf16x8 pa1, bf16x8 pa2, bf16x8 pa3) {
  const s16x4 l0 = tr_read<v_rd_off(D0, 0, 0)>(vb), h0 = tr_read<v_rd_off(D0, 0, 1)>(vb), l1 = tr_read<v_rd_off(D0, 1, 0)>(vb), h1 = tr_read<v_rd_off(D0, 1, 1)>(vb);
  const s16x4 l2 = tr_read<v_rd_off(D0, 2, 0)>(vb), h2 = tr_read<v_rd_off(D0, 2, 1)>(vb), l3 = tr_read<v_rd_off(D0, 3, 0)>(vb), h3 = tr_read<v_rd_off(D0, 3, 1)>(vb);
  asm volatile("s_waitcnt lgkmcnt(0)" ::: "memory"); SBAR();
#define PK(L, H) (bf16x8){L[0], L[1], L[2], L[3], H[0], H[1], H[2], H[3]}
  od = __builtin_amdgcn_mfma_f32_32x32x16_bf16(pa0, PK(l0, h0), od, 0, 0, 0);
  od = __builtin_amdgcn_mfma_f32_32x32x16_bf16(pa1, PK(l1, h1), od, 0, 0, 0);
  od = __builtin_amdgcn_mfma_f32_32x32x16_bf16(pa2, PK(l2, h2), od, 0, 0, 0);
  od = __builtin_amdgcn_mfma_f32_32x32x16_bf16(pa3, PK(l3, h3), od, 0, 0, 0);
#undef PK
}
__device__ __forceinline__ void pv_d0(f32x16* o, int vb, bf16x8 pa0, bf16x8 pa1, bf16x8 pa2, bf16x8 pa3) {
  pv_one<0>(o[0], vb, pa0, pa1, pa2, pa3); pv_one<1>(o[1], vb, pa0, pa1, pa2, pa3); pv_one<2>(o[2], vb, pa0, pa1, pa2, pa3); pv_one<3>(o[3], vb, pa0, pa1, pa2, pa3);
}
__device__ __forceinline__ void win_bias_mask(f32x16& p0, f32x16& p1, int dq, const float* lut, int hi) {
  constexpr float C = SCALE * LOG2E; const float NEG = -__builtin_inff();
  const int i00 = dq + 4 * hi + 128;
#pragma unroll
  for (int r = 0; r < 16; ++r) { const int c = (r & 3) + 8 * (r >> 2);
    const int i0 = i00 + c, i1 = i0 + 32;
    const bool v0 = (unsigned)i0 <= 256u, v1 = (unsigned)i1 <= 256u;
    const float b0 = lut[v0 ? i0 : 0], b1 = lut[v1 ? i1 : 0];
    p0[r] = v0 ? fmaf(p0[r], C, b0) : NEG; p1[r] = v1 ? fmaf(p1[r], C, b1) : NEG; }
}

template <bool WIN>
__device__ __forceinline__ void attn_body(const bf16* __restrict__ Qb, const bf16* __restrict__ Kh, const bf16* __restrict__ Vh,
                                          bf16* __restrict__ Ob, int seq, int P0, const float* lut, float sink2, char* lds) {
  int tid_ = threadIdx.x; asm volatile("" : "+v"(tid_));
  const int tid = tid_, wid = __builtin_amdgcn_readfirstlane(tid >> 6), lane = tid & 63, r32 = lane & 31, hi = lane >> 5;
  constexpr int SD = WIN ? 1 : 2;
  bf16* V_lds = (bf16*)lds; bf16* K_lds = (bf16*)(lds + 2 * SHM_V);
  float* ws = (float*)(lds + 2 * SHM_V + 2 * SHM_K) + wid * 64; float* li_l = ws; float* al_l = ws + 32;
  float m_reg = -1e30f, l_reg = 0; f32x16 o[4] = {}; bf16x8 qr[8];
  const bf16* Qw = Qb + (long)(wid * QBLK + r32) * LDQ + hi * 8;
#pragma unroll
  for (int d0 = 0; d0 < 8; ++d0) qr[d0] = ld8(Qw + d0 * 16);
  const int sr = tid >> 4, sc = (tid & 15) * 8, vst0 = v_st(sr, sc), vst1 = v_st(32 + sr, sc);
  const int vb0 = (int)(uintptr_t)V_lds + v_rd_base(lane);
  int kb0 = 0, NT = seq / KVBLK;
  if (WIN) { int jlo = P0 / KVBLK - 2; if (jlo < 0) jlo = 0; int jhi = P0 / KVBLK + 6; if (jhi > seq / KVBLK) jhi = seq / KVBLK; kb0 = jlo * KVBLK; NT = jhi - jlo; }
  const int qpos = P0 + wid * QBLK + r32;
  struct { bf16x8 vs0, vs1, ks0, ks1; } sr_[SD];
#define SLOAD(i, k0) do { sr_[i].vs0 = ld8(&Vh[(long)(kb0 + (k0) + sr) * LDK + sc]); sr_[i].vs1 = ld8(&Vh[(long)(kb0 + (k0) + 32 + sr) * LDK + sc]); \
    sr_[i].ks0 = ld8(&Kh[(long)(kb0 + (k0) + sr) * LDK + sc]); sr_[i].ks1 = ld8(&Kh[(long)(kb0 + (k0) + 32 + sr) * LDK + sc]); } while (0)
#define SWRITE(b, i) do { *(bf16x8*)((char*)V_lds + (b) * SHM_V + vst0) = sr_[i].vs0;          \
    *(bf16x8*)((char*)V_lds + (b) * SHM_V + vst1) = sr_[i].vs1; int kc = sc * 2;               \
    *(bf16x8*)((char*)K_lds + (b) * SHM_K + KSWZ(sr, kc)) = sr_[i].ks0;                       \
    *(bf16x8*)((char*)K_lds + (b) * SHM_K + KSWZ(32 + sr, kc)) = sr_[i].ks1; } while (0)
#define SWAIT() do { if constexpr (SD == 2) asm volatile("s_waitcnt vmcnt(4)" ::: "memory"); else asm volatile("s_waitcnt vmcnt(0)" ::: "memory"); } while (0)
#define RESC(a) do { if (__any((a) < 1.f)) { if (hi == 0) al_l[r32] = (a); asm volatile("s_waitcnt lgkmcnt(0)" ::: "memory"); \
    for (int d = 0; d < 4; ++d) for (int r = 0; r < 16; ++r) o[d][r] *= al_l[crow(r, hi)]; } } while (0)
#define PSM(P0_, P1_, mnX, alX, t) do { if (WIN) { win_bias_mask(P0_, P1_, kb0 + (t) * KVBLK - qpos, lut, hi); partialSM_w(P0_, P1_, m_reg, mnX, alX); } else partialSM(P0_, P1_, m_reg, mnX, alX); } while (0)
  f32x16 pA0, pA1, pB0, pB1; float mnA, mnB, alA, alB; bf16x8 pa0, pa1, pa2, pa3;
  constexpr int SE = 0, SO = SD - 1;
  SLOAD(SE, 0); asm volatile("s_waitcnt vmcnt(0)" ::: "memory"); SWRITE(0, SE); __syncthreads();
  qkt(pA0, pA1, K_lds, qr, r32, hi); PSM(pA0, pA1, mnA, alA, 0);
  SLOAD(SO, KVBLK); if constexpr (SD == 2) { if (2 < NT) SLOAD(SE, 2 * KVBLK); }
  SWAIT(); SWRITE(1, SO); __syncthreads();
  for (int j = 1; j + 1 < NT; j += 2) {
    SBAR(); qkt(pB0, pB1, (bf16*)((char*)K_lds + SHM_K), qr, r32, hi);
    finishSM(pA0, pA1, alA, l_reg, pa0, pa1, pa2, pa3); SBAR();
    SLOAD(SO, (j + SD) * KVBLK); SBAR();
    pv_d0(o, vb0, pa0, pa1, pa2, pa3); PSM(pB0, pB1, mnB, alB, j);
    __syncthreads(); SWAIT(); SWRITE(0, SE);
    RESC(alB); __syncthreads();
    SBAR(); qkt(pA0, pA1, K_lds, qr, r32, hi);
    finishSM(pB0, pB1, alB, l_reg, pa0, pa1, pa2, pa3); SBAR();
    if (SD == 1 || j + 3 < NT) SLOAD(SE, (j + 1 + SD) * KVBLK); SBAR();
    pv_d0(o, vb0 + (int)SHM_V, pa0, pa1, pa2, pa3); PSM(pA0, pA1, mnA, alA, j + 1);
    __syncthreads(); SWAIT(); SWRITE(1, SO);
    RESC(alA); __syncthreads();
  }
  SBAR(); qkt(pB0, pB1, (bf16*)((char*)K_lds + SHM_K), qr, r32, hi);
  finishSM(pA0, pA1, alA, l_reg, pa0, pa1, pa2, pa3); SBAR();
  pv_d0(o, vb0, pa0, pa1, pa2, pa3); PSM(pB0, pB1, mnB, alB, NT - 1);
  __syncthreads(); RESC(alB);
  finishSM(pB0, pB1, alB, l_reg, pa0, pa1, pa2, pa3); SBAR();
  pv_d0(o, vb0 + (int)SHM_V, pa0, pa1, pa2, pa3);
  if (WIN) l_reg += __builtin_amdgcn_exp2f(sink2 - m_reg);
  if (hi == 0) li_l[r32] = l_reg; asm volatile("s_waitcnt lgkmcnt(0)" ::: "memory");
  float rli[16];
#pragma unroll
  for (int r = 0; r < 16; ++r) rli[r] = __builtin_amdgcn_rcpf(li_l[crow(r, hi)]);
  bf16* Ow = Ob + (long)(wid * QBLK) * LDO;
#pragma unroll
  for (int r = 0; r < 16; ++r) { const int orow = crow(r, hi);
#pragma unroll
    for (int d0 = 0; d0 < 4; ++d0) { const float v = o[d0][r] * rli[r]; const float vn = __shfl_xor(v, 1);
      if ((r32 & 1) == 0) *(unsigned*)(Ow + (long)orow * LDO + d0 * 32 + r32) = cvtpk(v, vn); } }
  __syncthreads();
#undef SLOAD
#undef SWRITE
#undef SWAIT
#undef RESC
#undef PSM
}
#undef KSWZ
#undef SBAR
}
#define GAS __attribute__((address_space(1)))
#define LAS __attribute__((address_space(3)))
typedef unsigned short bf16;
typedef unsigned v4u __attribute__((ext_vector_type(4)));
typedef float f32x4 __attribute__((ext_vector_type(4)));
typedef short bf16x8 __attribute__((ext_vector_type(8)));
typedef GAS unsigned gu32;
typedef GAS unsigned long long gu64;
#define RLX_AGENT __ATOMIC_RELAXED, __HIP_MEMORY_SCOPE_AGENT
#define LDS_WAIT() asm volatile("s_waitcnt lgkmcnt(0)" ::: "memory")
#define VM_WAIT() asm volatile("s_waitcnt vmcnt(0)" ::: "memory")
__device__ __forceinline__ unsigned long long rt() { return __builtin_amdgcn_s_memrealtime(); }
__device__ __forceinline__ unsigned f2bf(float f) { unsigned u = __builtin_bit_cast(unsigned, f); return (u + 0x7fffu + ((u >> 16) & 1u)) >> 16; }
__device__ __forceinline__ unsigned pk2(float lo, float hi) { return f2bf(lo) | (f2bf(hi) << 16); }

#define XB_TMO      128
#define XB_XCNT(j)  (256  + 64 * (j))
#define XB_XSUB(j)  (1280 + 64 * (j))
#define XB_XGEN(j)  (2304 + 64 * (j))
#define XB_TOP      3328
#define XB_TOPGEN   3392
#define XCD_BAR_WORDS 3456
#define XB_SPIN_CAP (1u << 18)

__device__ __forceinline__ unsigned xb_ld(unsigned* p)              { return __hip_atomic_load(p, __ATOMIC_RELAXED, __HIP_MEMORY_SCOPE_AGENT); }
__device__ __forceinline__ unsigned xb_add(unsigned* p, unsigned v) { return __hip_atomic_fetch_add(p, v, __ATOMIC_RELAXED, __HIP_MEMORY_SCOPE_AGENT); }
__device__ __forceinline__ unsigned xb_xcc_id() { return (unsigned)__builtin_amdgcn_s_getreg((3 << 11) | 20) & 0xFu; }
#define XB_SPIN(cond, bar) do { unsigned _sp = 0; while (cond) { __builtin_amdgcn_s_sleep(1); \
    if ((++_sp & 255u) == 0u) { if (xb_ld(&(bar)[XB_TMO])) break; if (_sp > XB_SPIN_CAP) { atomicAdd(&(bar)[XB_TMO], 1u); break; } } } } while (0)

struct XcdBarrier {
    unsigned* bar; unsigned x;
    volatile LAS unsigned* st;
};

__device__ __forceinline__ XcdBarrier xcd_barrier_post(unsigned* bar, volatile LAS unsigned* st) {
    XcdBarrier b; b.bar = bar; b.x = xb_xcc_id(); b.st = st;
    if (threadIdx.x == 0) (void)xb_add(&bar[XB_XCNT(b.x)], 1u);
    return b;
}
__device__ __forceinline__ void xcd_barrier_complete(unsigned* bar, unsigned x, unsigned& nloc, unsigned& nx) {
    const unsigned G = gridDim.x * gridDim.y * gridDim.z;
    unsigned sum, cnt, mine, sp = 0u;
    for (;;) {
        sum = 0u; cnt = 0u; mine = 0u;
#pragma unroll
        for (unsigned j = 0; j < 16; ++j) { const unsigned c = xb_ld(&bar[XB_XCNT(j)]); sum += c; cnt += (c > 0u) ? 1u : 0u; mine = (j == x) ? c : mine; }
        if (sum == G) break;
        __builtin_amdgcn_s_sleep(1);
        if ((++sp & 255u) == 0u) { if (xb_ld(&bar[XB_TMO])) break; if (sp > XB_SPIN_CAP) { atomicAdd(&bar[XB_TMO], 1u); break; } }
    }
    nloc = mine > 0u ? mine : 1u; nx = cnt > 0u ? cnt : 1u;
}

__device__ __forceinline__ void xcd_barrier(const XcdBarrier& b) {
    asm volatile("s_waitcnt vmcnt(0)" ::: "memory");
    __syncthreads();
    if (threadIdx.x == 0) {
        unsigned* bar = b.bar;
        __builtin_amdgcn_s_waitcnt(0);
        unsigned nloc = b.st[0], nx = b.st[1];
        if (nloc == 0u) { xcd_barrier_complete(bar, b.x, nloc, nx); b.st[0] = nloc; b.st[1] = nx; }
        const unsigned old = xb_add(&bar[XB_XSUB(b.x)], 1u);
        const unsigned gen = old / nloc;
        if (old + 1u == (gen + 1u) * nloc) {
            __builtin_amdgcn_fence(__ATOMIC_RELEASE, "agent");
            asm volatile("s_waitcnt vmcnt(0)" ::: "memory");
            const unsigned og = xb_add(&bar[XB_TOP], 1u);
            const unsigned tg = og / nx;
            if (og + 1u == (tg + 1u) * nx) xb_add(&bar[XB_TOPGEN], 1u);
            else XB_SPIN(xb_ld(&bar[XB_TOPGEN]) == tg, bar);
            __builtin_amdgcn_fence(__ATOMIC_ACQUIRE, "agent");
            xb_add(&bar[XB_XGEN(b.x)], 1u);
            asm volatile("s_waitcnt vmcnt(0)" ::: "memory");
        } else {
            XB_SPIN(xb_ld(&bar[XB_XGEN(b.x)]) == gen, bar);
            __builtin_amdgcn_fence(__ATOMIC_ACQUIRE, "agent");
            asm volatile("s_waitcnt vmcnt(0)" ::: "memory");
        }
    }
    __syncthreads();
}
constexpr int NWAVES = 8;
constexpr int DM = 2048, DEPTH = 4, NIN = 3072, DFF = 8192, MODW = 6 * DM;
constexpr int T0 = 16384, T1 = 8192;
constexpr int M = T0 + 2 * T1;
constexpr float EPS = 1e-6f;
constexpr float LOG2E = 1.4426950408889634f;

constexpr size_t MiB = 1u << 20;
constexpr size_t WS_CTL = 0, CTL_ZERO_BYTES = 1 * MiB;
constexpr size_t WS_MOD = 1 * MiB;
constexpr size_t WS_ROPE = 2 * MiB;
constexpr size_t WS_W = 4 * MiB, W_LAYER = 84 * MiB;
constexpr size_t W_IN = 0, W_OUT = 12 * MiB, W_UP = 20 * MiB, W_DOWN = 52 * MiB;
constexpr size_t WS_XN = WS_W + DEPTH * W_LAYER;
constexpr size_t WS_QKV = WS_XN + 128 * MiB;
constexpr size_t WS_O = WS_QKV + 192 * MiB;
constexpr size_t WS_H = WS_O + 128 * MiB;
constexpr size_t WS_END = WS_H + 512 * MiB;
constexpr int CW_BAR = 4096;

constexpr int RING_OFF = 0, RING_BYTES = 131072;
constexpr int LDSCTL_OFF = RING_BYTES, MISC_OFF = LDSCTL_OFF + 320;
constexpr int LUT_OFF = LDSCTL_OFF + 512, LUT_STRIDE = 260;
constexpr int LDS_BYTES = 147456;
static_assert(LUT_OFF + 8 * LUT_STRIDE * 4 <= LDS_BYTES, "LDS map");

struct Args { const float* in[19]; float* out; unsigned char* ws; };

__device__ __forceinline__ float wave_sum(float v) {
#pragma unroll
    for (int o = 1; o < 64; o <<= 1) v += __shfl_xor(v, o);
    return v;
}
__device__ __forceinline__ float bf_lo(unsigned w) { return __builtin_bit_cast(float, w << 16); }
__device__ __forceinline__ float bf_hi(unsigned w) { return __builtin_bit_cast(float, w & 0xffff0000u); }
__device__ __forceinline__ int seq_of_row(int m) { return m < T0 ? 0 : (m < T0 + T1 ? 1 : 2); }
__device__ __forceinline__ int seq_start(int s) { return s == 0 ? 0 : (s == 1 ? T0 : T0 + T1); }

__device__ __forceinline__ void p0_transpose_item(const float* W, int K, int N, bf16* WT, LAS float* scr, int item, int lane) {
    const int nblk = N / 32, kb = item / nblk, nb = item % nblk, k0 = 64 * kb, n0 = 32 * nb;
#pragma unroll 8
    for (int i = 0; i < 32; ++i) { const int kk = 2 * i + (lane >> 5); scr[kk * 33 + (lane & 31)] = W[(size_t)(k0 + kk) * N + n0 + (lane & 31)]; }
    LDS_WAIT(); asm volatile("" ::: "memory");
    const int c = lane & 7;
#pragma unroll
    for (int j = 0; j < 4; ++j) { const int n = (lane >> 3) + 8 * j; const LAS float* s = scr + (8 * c) * 33 + n;
        v4u o; o.x = pk2(s[0 * 33], s[1 * 33]); o.y = pk2(s[2 * 33], s[3 * 33]); o.z = pk2(s[4 * 33], s[5 * 33]); o.w = pk2(s[6 * 33], s[7 * 33]);
        *(GAS v4u*)(WT + (size_t)(n0 + n) * K + k0 + 8 * c) = o; }
    LDS_WAIT(); asm volatile("" ::: "memory");
}

template <int IDX> __device__ __forceinline__ const float* kin() {
    unsigned long long v; asm volatile("s_load_dwordx2 %0, %1, %2\n\ts_waitcnt lgkmcnt(0)" : "=s"(v) : "s"(__builtin_amdgcn_kernarg_segment_ptr()), "n"(IDX * 8)); return (const float*)(const GAS float*)v; }
#define KIN(i) kin<(i)>()
#define OUTP() ((float*)kin<19>())
#define WSP() ((unsigned char*)kin<20>())
#define P_MOD() ((float*)(WSP() + WS_MOD))
#define P_ROPE() ((float*)(WSP() + WS_ROPE))
#define P_XN() ((bf16*)(WSP() + WS_XN))
#define P_QKV() ((bf16*)(WSP() + WS_QKV))
#define P_O() ((bf16*)(WSP() + WS_O))
#define P_H() ((bf16*)(WSP() + WS_H))
#define LAUNDER_LANE() int lane_ = threadIdx.x & 63; asm volatile("" : "+v"(lane_)); const int lane = lane_

__global__ void __launch_bounds__(NWAVES * 64, 2) fwd_kernel(Args args) {
    extern __shared__ __attribute__((aligned(16))) unsigned char lds[];
    LAS unsigned char* ldsl = (LAS unsigned char*)lds;
    volatile LAS unsigned* MISC = (volatile LAS unsigned*)(ldsl + MISC_OFF);
    const int wave = __builtin_amdgcn_readfirstlane((int)threadIdx.x >> 6);
    const int G = gridDim.x; const int bx = blockIdx.x;
    const int vcu = (G % 8 == 0) ? (bx % 8) * (G / 8) + bx / 8 : bx;
    const int gw = vcu * NWAVES + wave, NGW = G * NWAVES;

    for (int u = threadIdx.x; u < (LUT_OFF - LDSCTL_OFF) / 4; u += NWAVES * 64) ((LAS unsigned*)(ldsl + LDSCTL_OFF))[u] = 0u;
    __syncthreads();
    XcdBarrier bar = xcd_barrier_post((unsigned*)((gu32*)(WSP() + WS_CTL) + CW_BAR), MISC + 8);
#define GRID_BAR() xcd_barrier(bar)

    {   const int tid = threadIdx.x; LAUNDER_LANE();
        { float* lutw = (float*)(lds + LUT_OFF); const float* rel_bias = KIN(17);
          for (int i = tid; i < 8 * 257; i += NWAVES * 64) { const int h = i / 257, ri = i % 257, rel = ri - 128, n = rel < 0 ? -rel : rel;
              int bk; if (n < 8) bk = n; else { int lg = (31 - __builtin_clz(n * n)) - 6 + 8; bk = lg > 15 ? 15 : lg; }
              if (rel > 0) bk += 16;
              lutw[h * LUT_STRIDE + ri] = rel_bias[bk * 8 + h] * LOG2E; } }
        { const int gid = vcu * (NWAVES * 64) + tid;
          if (gid < 256 * 32) { const int p = gid >> 5, j = gid & 31;
              double f = 1.0; for (int i = 0; i < j; ++i) f *= 0.74989420933245582730;
              const float ang = (float)p * (float)f;
              const double rev = (double)ang * 0.15915494309189533577; const double fr = rev - __builtin_rint(rev); const double xx = fr * 6.28318530717958647693, x2 = xx * xx;
              double sn = 1.0, cs = 1.0;
              for (int k = 14; k >= 1; --k) { sn = 1.0 - sn * x2 / (double)((2 * k) * (2 * k + 1)); cs = 1.0 - cs * x2 / (double)((2 * k - 1) * (2 * k)); }
              P_ROPE()[gid] = (float)cs; P_ROPE()[256 * 32 + gid] = (float)(xx * sn); } }
        { LAS float* scr = (LAS float*)(ldsl + RING_OFF + wave * 16384);
          constexpr int I_IN = (DM / 64) * (NIN / 32), I_OUT = (DM / 64) * (DM / 32), I_UP = (DM / 64) * (DFF / 32), I_DN = (DFF / 64) * (DM / 32), I_L = I_IN + I_OUT + I_UP + I_DN;
          for (int it = gw; it < DEPTH * I_L; it += NGW) { const int l = it / I_L; int r = it % I_L; unsigned char* wl = WSP() + WS_W + (size_t)l * W_LAYER;
              if (r < I_IN) { p0_transpose_item(KIN(7) + (size_t)l * DM * NIN, DM, NIN, (bf16*)(wl + W_IN), scr, r, lane); continue; } r -= I_IN;
              if (r < I_OUT) { p0_transpose_item(KIN(13) + (size_t)l * DM * DM, DM, DM, (bf16*)(wl + W_OUT), scr, r, lane); continue; } r -= I_OUT;
              if (r < I_UP) { p0_transpose_item(KIN(15) + (size_t)l * DM * DFF, DM, DFF, (bf16*)(wl + W_UP), scr, r, lane); continue; } r -= I_UP;
              p0_transpose_item(KIN(16) + (size_t)l * DFF * DM, DFF, DM, (bf16*)(wl + W_DOWN), scr, r, lane); } }
        __syncthreads();
        { float* scv = (float*)lds; float* part = (float*)(lds + 32768); const float* c_prompt = KIN(2); const float* c_sample = KIN(3);
          for (int i = tid; i < 3 * DM; i += NWAVES * 64) { const int s = i / DM, d = i % DM; const float c = s == 0 ? c_prompt[d] : c_sample[(s - 1) * DM + d]; scv[i] = c / (1.f + __expf(-c)); }
          __syncthreads();
          for (int grp = vcu; grp < DEPTH * (MODW / 64); grp += G) { const int l = grp / (MODW / 64), e0 = (grp % (MODW / 64)) * 64;
              const float* w = KIN(4) + (size_t)l * DM * MODW + e0 + lane; float a0 = 0.f, a1 = 0.f, a2 = 0.f; const int d0 = wave * 256;
#pragma unroll 8
              for (int d = d0; d < d0 + 256; ++d) { const float wv = w[(size_t)d * MODW]; a0 = fmaf(scv[d], wv, a0); a1 = fmaf(scv[DM + d], wv, a1); a2 = fmaf(scv[2 * DM + d], wv, a2); }
              part[(wave * 3 + 0) * 64 + lane] = a0; part[(wave * 3 + 1) * 64 + lane] = a1; part[(wave * 3 + 2) * 64 + lane] = a2;
              __syncthreads();
              if (tid < 192) { const int s = tid >> 6, ln = tid & 63; float acc = KIN(5)[l * MODW + e0 + ln];
#pragma unroll
                  for (int w8 = 0; w8 < 8; ++w8) acc += part[(w8 * 3 + s) * 64 + ln];
                  P_MOD()[(size_t)(l * 3 + s) * MODW + e0 + ln] = acc; }
              __syncthreads(); } }
    }
    GRID_BAR();

    for (int hl = 0; hl < 2 * DEPTH; ++hl) {
        const int l = hl >> 1, mlp = hl & 1;
        {   LAUNDER_LANE();
            const float* xb0 = hl == 0 ? KIN(0) : OUTP(); const float* xb1 = hl == 0 ? KIN(1) : OUTP() + (size_t)T0 * DM;
            const float* gn = (mlp ? KIN(14) : KIN(6)) + l * DM; const float* modl = P_MOD() + (size_t)l * 3 * MODW + (mlp ? 3 * DM : 0); bf16* XN = P_XN();
            for (int m = gw; m < M; m += NGW) {
                const int s = seq_of_row(m); const float* xr = m < T0 ? xb0 + (size_t)m * DM : xb1 + (size_t)(m - T0) * DM; const float* md = modl + s * MODW;
                f32x4 v[8]; float ss = 0.f;
#pragma unroll
                for (int j = 0; j < 8; ++j) { v[j] = *(const f32x4*)(xr + 4 * lane + 256 * j); ss += (v[j].x * v[j].x + v[j].y * v[j].y) + (v[j].z * v[j].z + v[j].w * v[j].w); }
                const float rinv = __builtin_amdgcn_rsqf(wave_sum(ss) * (1.f / DM) + EPS);
#pragma unroll
                for (int j = 0; j < 8; ++j) { const int c = 4 * lane + 256 * j; const f32x4 g = *(const f32x4*)(gn + c), sc = *(const f32x4*)(md + DM + c), sh = *(const f32x4*)(md + c);
                    const f32x4 o = v[j] * rinv * g * (sc + 1.f) + sh;
                    *(unsigned long long*)(XN + (size_t)m * DM + c) = (unsigned long long)pk2(o.x, o.y) | ((unsigned long long)pk2(o.z, o.w) << 32); }
            }
        }
        GRID_BAR();
        {   const int N = mlp ? DFF : NIN; const bf16* Bt = (const bf16*)(WSP() + WS_W + (size_t)l * W_LAYER + (mlp ? W_UP : W_IN));
            pg8::Gemm g{P_XN(), Bt, M, N, DM}; pg8::StaticOrder S; S.init(M, N, G, bx);
            pg8::EpiBf16 E{mlp ? P_H() : P_QKV(), N, mlp};
            pg8::gemm_phase<pg8::EpiBf16, pg8::StaticOrder, true, true>(ldsl + RING_OFF, g, S, E); }
        GRID_BAR();
        if (!mlp) {
            {   LAUNDER_LANE();
                bf16* QKV = P_QKV(); const float* ROPE_C = P_ROPE(); const float* ROPE_S = ROPE_C + 256 * 32; const float* qn = KIN(8) + l * 128; const float* kn = KIN(9) + l * 128;
                for (int m = gw; m < M; m += NGW) {
                    const int s = seq_of_row(m), t = m - seq_start(s), rowid = t >> 6, colid = t & 63, l32 = lane & 31, seg = l32 >> 3, pos = seg < 2 ? rowid : colid;
                    const f32x4 cs = *(const f32x4*)(ROPE_C + pos * 32 + 4 * (l32 & 7)), sn = *(const f32x4*)(ROPE_S + pos * 32 + 4 * (l32 & 7));
#pragma unroll
                    for (int it = 0; it < 5; ++it) { const int head = it * 2 + (lane >> 5);
                        bf16* p = QKV + (size_t)m * NIN + head * 128 + 4 * l32;
                        const unsigned long long w = *(const unsigned long long*)p; const unsigned wlo = (unsigned)w, whi = (unsigned)(w >> 32);
                        f32x4 v = {bf_lo(wlo), bf_hi(wlo), bf_lo(whi), bf_hi(whi)};
                        float ss = (v.x * v.x + v.y * v.y) + (v.z * v.z + v.w * v.w);
#pragma unroll
                        for (int o = 1; o < 32; o <<= 1) ss += __shfl_xor(ss, o);
                        const float rinv = __builtin_amdgcn_rsqf(ss * (1.f / 128.f) + EPS);
                        const f32x4 g = *(const f32x4*)((head < 8 ? qn : kn) + 4 * l32);
                        v = v * rinv * g;
                        f32x4 pn; pn.x = __shfl_xor(v.x, 8); pn.y = __shfl_xor(v.y, 8); pn.z = __shfl_xor(v.z, 8); pn.w = __shfl_xor(v.w, 8);
                        const f32x4 o = (seg & 1) ? v * cs + pn * sn : v * cs - pn * sn;
                        *(unsigned long long*)p = (unsigned long long)pk2(o.x, o.y) | ((unsigned long long)pk2(o.z, o.w) << 32); }
                }
            }
            GRID_BAR();
            {   const int x = vcu >> 5, c32 = vcu & 31;
                const att::bf16* QKV = (const att::bf16*)P_QKV(); att::bf16* OB = (att::bf16*)P_O();
                for (int i = 0; i < 4; ++i) {
                    int h, qb, kvh, seq; size_t r0;
                    if (i < 2) { h = x; qb = c32 * 2 + i; kvh = h >> 2; seq = T0; r0 = 0; }
                    else { const int combo = x >> 1, s = 1 + (combo >> 1), ui = ((x & 1) * 32 + c32) * 2 + (i - 2); kvh = combo & 1; h = kvh * 4 + (ui >> 5); qb = ui & 31; seq = T1; r0 = (size_t)seq_start(s); }
                    att::attn_body<false>(QKV + (r0 + qb * 256) * NIN + h * 128, QKV + r0 * NIN + 1024 + kvh * 128, QKV + r0 * NIN + 1280 + kvh * 128,
                                          OB + (r0 + qb * 256) * DM + h * 128, seq, 0, nullptr, 0.f, (char*)lds); }
                const float* lut = (const float*)(lds + LUT_OFF) + x * LUT_STRIDE; const float sink2 = KIN(10)[l * 8 + x] * LOG2E;
                for (int i = 0; i < 4; ++i) { const int h = x, rb = c32 * 4 + i, kvh = h >> 2, s = rb < 64 ? 0 : (rb < 96 ? 1 : 2); const size_t r0 = (size_t)seq_start(s);
                    att::attn_body<true>(QKV + (size_t)(rb * 256) * NIN + 1536 + h * 128, QKV + r0 * NIN + 2560 + kvh * 128, QKV + r0 * NIN + 2816 + kvh * 128,
                                         OB + (size_t)(rb * 256) * DM + 1024 + h * 128, s == 0 ? T0 : T1, rb * 256 - (int)r0, lut, sink2, (char*)lds); }
            }
            GRID_BAR();
            {   LAUNDER_LANE();
                bf16* OB = P_O(); const float* ga = KIN(11) + l * 1024; const float* gb = KIN(12) + l * 1024;
                for (int m = gw; m < M; m += NGW) {
                    bf16* p = OB + (size_t)m * DM + 8 * lane; v4u w[4]; float ssa = 0.f, ssb = 0.f;
#pragma unroll
                    for (int j = 0; j < 4; ++j) { w[j] = *(const v4u*)(p + 512 * j);
                        float q = 0.f;
#pragma unroll
                        for (int e = 0; e < 4; ++e) { const float a = bf_lo(w[j][e]), b = bf_hi(w[j][e]); q += a * a + b * b; }
                        if (j < 2) ssa += q; else ssb += q; }
                    const float ra = __builtin_amdgcn_rsqf(wave_sum(ssa) * (1.f / 1024.f) + EPS), rb = __builtin_amdgcn_rsqf(wave_sum(ssb) * (1.f / 1024.f) + EPS);
#pragma unroll
                    for (int j = 0; j < 4; ++j) { const int c = 8 * lane + 512 * j; const float* gp = j < 2 ? ga + c : gb + (c - 1024); const float r = j < 2 ? ra : rb;
                        const f32x4 g0 = *(const f32x4*)gp, g1 = *(const f32x4*)(gp + 4); v4u o;
                        o.x = pk2(bf_lo(w[j].x) * r * g0.x, bf_hi(w[j].x) * r * g0.y); o.y = pk2(bf_lo(w[j].y) * r * g0.z, bf_hi(w[j].y) * r * g0.w);
                        o.z = pk2(bf_lo(w[j].z) * r * g1.x, bf_hi(w[j].z) * r * g1.y); o.w = pk2(bf_lo(w[j].w) * r * g1.z, bf_hi(w[j].w) * r * g1.w);
                        *(v4u*)(p + 512 * j) = o; }
                }
            }
            GRID_BAR();
        }
        {   const int K = mlp ? DFF : DM; const bf16* Bt = (const bf16*)(WSP() + WS_W + (size_t)l * W_LAYER + (mlp ? W_DOWN : W_OUT));
            pg8::Gemm g{mlp ? P_H() : P_O(), Bt, M, DM, K}; pg8::StaticOrder S; S.init(M, DM, G, bx);
            pg8::EpiRes E{hl == 0 ? KIN(0) : OUTP(), hl == 0 ? KIN(1) : OUTP() + (size_t)T0 * DM, OUTP(), P_MOD() + (size_t)l * 3 * MODW + (mlp ? 5 * DM : 2 * DM)};
            pg8::gemm_phase<pg8::EpiRes, pg8::StaticOrder, true, true>(ldsl + RING_OFF, g, S, E); }
        GRID_BAR();
    }
    {   LAUNDER_LANE(); float* outp = OUTP(); const float* gf = KIN(18);
        for (int m = gw; m < M; m += NGW) {
            float* xr = outp + (size_t)m * DM; f32x4 v[8]; float ss = 0.f;
#pragma unroll
            for (int j = 0; j < 8; ++j) { v[j] = *(const f32x4*)(xr + 4 * lane + 256 * j); ss += (v[j].x * v[j].x + v[j].y * v[j].y) + (v[j].z * v[j].z + v[j].w * v[j].w); }
            const float rinv = __builtin_amdgcn_rsqf(wave_sum(ss) * (1.f / DM) + EPS);
#pragma unroll
            for (int j = 0; j < 8; ++j) { const int c = 4 * lane + 256 * j; const f32x4 g = *(const f32x4*)(gf + c); *(f32x4*)(xr + c) = v[j] * rinv * g; }
        }
    }
#undef GRID_BAR
}

extern "C" void kernel_launch(void* const* d_in, const int* in_sizes, int n_in, void* d_out, int out_size, void* d_ws, size_t ws_size, hipStream_t stream) {
    static int grid = 0;
    if (grid == 0) {
        if (n_in != 19 || in_sizes[0] != T0 * DM || out_size != M * DM || ws_size < WS_END) { fprintf(stderr, "kernel_launch: shape mismatch (n_in %d, in0 %d, out %d, ws %zu need %zu)\n", n_in, n_in > 0 ? in_sizes[0] : -1, out_size, ws_size, (size_t)WS_END); grid = -1; return; }
        int dev = 0, cus = 0;
        if (hipGetDevice(&dev) != hipSuccess || hipDeviceGetAttribute(&cus, hipDeviceAttributeMultiprocessorCount, dev) != hipSuccess) { grid = -1; return; }
        if (hipFuncSetAttribute((const void*)fwd_kernel, hipFuncAttributeMaxDynamicSharedMemorySize, LDS_BYTES) != hipSuccess) { fprintf(stderr, "kernel_launch: hipFuncSetAttribute failed\n"); grid = -1; return; }
        (void)hipGetLastError();
        grid = cus;
        if (grid != 256) fprintf(stderr, "kernel_launch: %d CUs; the attention dealing assumes 256\n", grid);
    }
    if (grid < 0) return;
    if (hipMemsetAsync((char*)d_ws + WS_CTL, 0, CTL_ZERO_BYTES, stream) != hipSuccess) return;
    Args a{};
    for (int i = 0; i < 19; ++i) a.in[i] = (const float*)d_in[i];
    a.out = (float*)d_out; a.ws = (unsigned char*)d_ws;
    hipLaunchKernelGGL(fwd_kernel, dim3(grid), dim3(NWAVES * 64), LDS_BYTES, stream, a);
    const hipError_t le = hipPeekAtLastError();
    if (le != hipSuccess) fprintf(stderr, "kernel_launch: launch failed: %s\n", hipGetErrorName(le));
}
```

```cpp
#include <hip/hip_runtime.h>
#include <hip/hip_bf16.h>
#include <cstdio>
#include <cstdint>
namespace pg8 {
#define PG8_LAS __attribute__((address_space(3)))
typedef unsigned short bf16_t;
typedef short bf16x8 __attribute__((ext_vector_type(8)));
typedef float f32x4 __attribute__((ext_vector_type(4)));
typedef unsigned u32x4 __attribute__((ext_vector_type(4)));
constexpr int BM = 256, BK = 64, HALF = 128, HTB = HALF * BK * 2  , STAGE_BYTES = 8 * HTB, NXCD = 8, WGM = 8;

__host__ __device__ __forceinline__ int lds_byte(int r, int c) { const int st = (r >> 4) * 2 + (c >> 5), rr = r & 15, cc = c & 31, ob = rr * 64 + cc * 2; return st * 1024 + (ob ^ (((ob >> 9) & 1) << 5)); }
__host__ __device__ __forceinline__ void stage_rc(int b, int& R, int& C) { const int st = b / 1024, sb = b % 1024, swz = sb ^ (((sb >> 9) & 1) << 5); R = (st >> 1) * 16 + swz / 64; C = (st & 1) * 32 + (swz % 64) / 2; }
__host__ __device__ __forceinline__ int perm32(int rho) { const int n = rho >> 4, i = rho & 15; return 8 * (i >> 2) + 4 * n + (i & 3); }

struct Unit { int pm, pn; };
struct Gemm { const bf16_t* A; const bf16_t* Bt; int M, N, K; };

struct StaticOrder {
    int nM, nN, nwg, G, c, wgm; bool rev;
    __host__ __device__ void init(int M, int N, int G_, int c_, int wgm_ = WGM, bool rev_ = false) { nM = M / BM; nN = N / BM; nwg = nM * nN; G = G_; c = c_; wgm = wgm_; rev = rev_; }
    __host__ __device__ bool next(int i, Unit& u) const {
        const long L = (long)i * G + c; if (L >= nwg) return false;
        int wgid = (int)L; { const int q = nwg / NXCD, r = nwg % NXCD, xcd = wgid % NXCD, off = wgid / NXCD; wgid = (xcd < r ? xcd * (q + 1) : r * (q + 1) + (xcd - r) * q) + off; }
        const int nig = wgm * nN, gid = wgid / nig, fm = gid * wgm, gsz = (nM - fm) < wgm ? (nM - fm) : wgm;
        u.pm = fm + ((wgid % nig) % gsz); u.pn = (wgid % nig) / gsz; if (rev) u.pm ^= 15; return true;
    }
    __device__ __forceinline__ void a_ready(const Unit&) const {}
    __device__ __forceinline__ void done(const Unit&) const {}
};

__device__ __forceinline__ unsigned cvt_pk_bf16(float lo, float hi) { unsigned r; asm volatile("v_cvt_pk_bf16_f32 %0, %1, %2" : "=v"(r) : "v"(lo), "v"(hi)); return r; }
typedef float f32x2 __attribute__((ext_vector_type(2)));
__device__ __forceinline__ int seq_of_pm(int pm) { return pm < 64 ? 0 : (pm < 96 ? 1 : 2); }
__device__ __forceinline__ float relu1(float x) { float r; asm("v_max_f32_e32 %0, 0, %1" : "=v"(r) : "v"(x)); return r; }
struct EpiBf16 {
    static constexpr bool PERM = true, AFTER_DRAIN = false;
    bf16_t* O; int ldc; int act; const float* ssp; const float* bv; PG8_LAS f32x2* tab; PG8_LAS float* vec;
    __device__ __forceinline__ void midk(f32x4 (&)[2][2][4][2], const Unit&, int, int) const {}
    __device__ __forceinline__ bool has_midk() const { return false; }
    struct Pre { f32x4 a; float v; };
    __device__ __forceinline__ Pre prep_load(const Unit& u, int tid) const {
        const int row = tid >> 1, h = tid & 1; Pre r; r.a = *(const f32x4*)(ssp + (size_t)(u.pm * BM + row) * 8 + 4 * h);
        r.v = bv[(size_t)seq_of_pm(u.pm) * ldc + u.pn * BM + (tid & 255)]; return r;
    }
    __device__ __forceinline__ void prep_commit(const Pre& r, int tid) const {
        const int row = tid >> 1, h = tid & 1; const f32x4 a = r.a;
        float s = (a[0] + a[1]) + (a[2] + a[3]);
        const float o = __builtin_bit_cast(float, __builtin_amdgcn_mov_dpp(__builtin_bit_cast(int, s), 0xB1, 0xF, 0xF, true)); s = h ? o + s : s + o;
        if (h == 0) tab[row] = (f32x2){__builtin_amdgcn_rsqf(s * (1.f / 2048.f) + 1e-6f), 0.f};
        if (tid < 256) vec[tid] = r.v;
    }
    __device__ __forceinline__ void operator()(const f32x4 (&acc)[2][2][4][2], const Unit& u, int wr, int wc, int fr, int fq) const {
        const int row0 = u.pm * BM + wr * 64 + fr; const int col0 = u.pn * BM + wc * 32 + 8 * fq;
        f32x4 b[2][2];
#pragma unroll
        for (int bj = 0; bj < 2; ++bj)
#pragma unroll
            for (int n = 0; n < 2; ++n) b[bj][n] = *(const PG8_LAS f32x4*)(vec + wc * 32 + 8 * fq + bj * HALF + 4 * n);
#pragma unroll
        for (int ai = 0; ai < 2; ++ai)
#pragma unroll
            for (int m = 0; m < 4; ++m) { bf16_t* rowp = O + (size_t)(row0 + ai * HALF + m * 16) * ldc + col0;
                const float r = tab[ai * HALF + wr * 64 + m * 16 + fr].x;
#pragma unroll
                for (int bj = 0; bj < 2; ++bj) { f32x4 v0 = acc[ai][bj][m][0] * r + b[bj][0], v1 = acc[ai][bj][m][1] * r + b[bj][1];
                    if (act) {
#pragma unroll
                        for (int j = 0; j < 4; ++j) { const float a = relu1(v0[j]), c = relu1(v1[j]); v0[j] = a * a; v1[j] = c * c; } }
                    u32x4 w; w.x = cvt_pk_bf16(v0[0], v0[1]); w.y = cvt_pk_bf16(v0[2], v0[3]); w.z = cvt_pk_bf16(v1[0], v1[1]); w.w = cvt_pk_bf16(v1[2], v1[3]);
                    *(u32x4*)(rowp + bj * HALF) = w; } }
    }
};
struct EpiRes {
    static constexpr bool PERM = true, AFTER_DRAIN = false;
    bf16_t* xb; const float* gate; const float* ssop; const float* gn; bf16_t* xn; float* sspn; PG8_LAS f32x2* tab; PG8_LAS float* stg; PG8_LAS float* vec;
    __device__ __forceinline__ bool has_midk() const { return ssop != nullptr; }
    struct Pre { f32x4 a, b; float v; };
    __device__ __forceinline__ Pre prep_load(const Unit& u, int tid) const {
        Pre r; r.a = (f32x4){0.f, 0.f, 0.f, 0.f}; r.b = r.a; const int s = seq_of_pm(u.pm), c = u.pn * BM + (tid & 255);
        r.v = tid < 256 ? gate[s * 12288 + c] : (gn ? gn[s * 2048 + c] : 0.f);
        if (!ssop) return r;
        const int row = tid >> 1, h = tid & 1; const f32x4* p = (const f32x4*)(ssop + (size_t)(u.pm * BM + row) * 16 + 8 * h);
        r.a = p[0]; r.b = p[1]; return r;
    }
    __device__ __forceinline__ void prep_commit(const Pre& r, int tid) const {
        vec[tid] = r.v;
        if (!ssop) return;
        const int row = tid >> 1, h = tid & 1; const f32x4 a = r.a, b = r.b;
        const float s = ((a[0] + a[1]) + (a[2] + a[3])) + ((b[0] + b[1]) + (b[2] + b[3])); const float o = __builtin_bit_cast(float, __builtin_amdgcn_mov_dpp(__builtin_bit_cast(int, s), 0xB1, 0xF, 0xF, true));
        const float sA = h ? o : s, sB = h ? s : o;
        const float qB = sB * (1.f / 1024.f) + 1e-6f;
        if (h == 0) tab[row] = (f32x2){__builtin_amdgcn_rsqf(sA * (1.f / 1024.f) + 1e-6f) * __builtin_amdgcn_sqrtf(qB), __builtin_amdgcn_rsqf(qB)};
    }
    __device__ __forceinline__ void midk(f32x4 (&acc)[2][2][4][2], const Unit& u, int wr, int fr) const {
#pragma unroll
        for (int ai = 0; ai < 2; ++ai)
#pragma unroll
            for (int m = 0; m < 4; ++m) { const float f = tab[ai * HALF + wr * 64 + m * 16 + fr].x;
#pragma unroll
                for (int bj = 0; bj < 2; ++bj)
#pragma unroll
                    for (int n = 0; n < 2; ++n) acc[ai][bj][m][n] *= f; }
    }
    __device__ __forceinline__ void operator()(const f32x4 (&acc)[2][2][4][2], const Unit& u, int wr, int wc, int fr, int fq) const {
        const int row0 = u.pm * BM + wr * 64 + fr, col0 = u.pn * BM + wc * 32 + 8 * fq;
        const PG8_LAS float* gl = vec + wc * 32 + 8 * fq; const PG8_LAS float* xl = gl + 256;
        u32x4 bw0[4][2], bw1[4][2];
#pragma unroll
        for (int m = 0; m < 4; ++m)
#pragma unroll
            for (int bj = 0; bj < 2; ++bj) bw0[m][bj] = *(const u32x4*)(xb + (size_t)(row0 + m * 16) * 2048 + col0 + bj * HALF);
        asm volatile("" ::: "memory");
#define EPIRES_GROUP(ai, m, BW) do { const size_t ro = (size_t)(row0 + (ai) * HALF + (m) * 16) * 2048 + col0; \
            const float pr = ssop ? tab[(ai) * HALF + wr * 64 + (m) * 16 + fr].y : 1.f; float sq = 0.f; \
            _Pragma("unroll") for (int bj = 0; bj < 2; ++bj) { const u32x4 b = BW[m][bj]; \
                const f32x4 g0 = *(const PG8_LAS f32x4*)(gl + bj * HALF), g1 = *(const PG8_LAS f32x4*)(gl + bj * HALF + 4); \
                f32x4 b0, b1; \
                b0[0] = __uint_as_float(b.x << 16); b0[1] = __uint_as_float(b.x & 0xffff0000u); b0[2] = __uint_as_float(b.y << 16); b0[3] = __uint_as_float(b.y & 0xffff0000u); \
                b1[0] = __uint_as_float(b.z << 16); b1[1] = __uint_as_float(b.z & 0xffff0000u); b1[2] = __uint_as_float(b.w << 16); b1[3] = __uint_as_float(b.w & 0xffff0000u); \
                const f32x4 x0 = b0 + g0 * (acc[ai][bj][m][0] * pr), x1 = b1 + g1 * (acc[ai][bj][m][1] * pr); \
                u32x4 w; w.x = cvt_pk_bf16(x0[0], x0[1]); w.y = cvt_pk_bf16(x0[2], x0[3]); w.z = cvt_pk_bf16(x1[0], x1[1]); w.w = cvt_pk_bf16(x1[2], x1[3]); \
                *(u32x4*)(xb + ro + bj * HALF) = w; \
                if (gn) { sq += ((x0[0] * x0[0] + x0[1] * x0[1]) + (x0[2] * x0[2] + x0[3] * x0[3])) + ((x1[0] * x1[0] + x1[1] * x1[1]) + (x1[2] * x1[2] + x1[3] * x1[3])); \
                    const f32x4 y0 = x0 * *(const PG8_LAS f32x4*)(xl + bj * HALF), y1 = x1 * *(const PG8_LAS f32x4*)(xl + bj * HALF + 4); \
                    u32x4 v; v.x = cvt_pk_bf16(y0[0], y0[1]); v.y = cvt_pk_bf16(y0[2], y0[3]); v.z = cvt_pk_bf16(y1[0], y1[1]); v.w = cvt_pk_bf16(y1[2], y1[3]); \
                    *(u32x4*)(xn + ro + bj * HALF) = v; } } \
            if (gn) { { auto r1_ = __builtin_amdgcn_permlane16_swap(__float_as_uint(sq), __float_as_uint(sq), false, false); sq = __uint_as_float(r1_[0]) + __uint_as_float(r1_[1]); }     \
                { auto r2_ = __builtin_amdgcn_permlane32_swap(__float_as_uint(sq), __float_as_uint(sq), false, false); sq = __uint_as_float(r2_[0]) + __uint_as_float(r2_[1]); }                        \
                if (fq == 0) stg[((ai) * HALF + wr * 64 + (m) * 16 + fr) * 4 + wc] = sq; } } while (0)
#pragma unroll
        for (int m = 0; m < 4; ++m) { EPIRES_GROUP(0, m, bw0);
            asm volatile("" ::: "memory");
#pragma unroll
            for (int bj = 0; bj < 2; ++bj) bw1[m][bj] = *(const u32x4*)(xb + (size_t)(row0 + HALF + m * 16) * 2048 + col0 + bj * HALF);
            asm volatile("" ::: "memory"); }
#pragma unroll
        for (int m = 0; m < 4; ++m) EPIRES_GROUP(1, m, bw1);
        asm volatile("" ::: "memory");
#undef EPIRES_GROUP
        if (gn) {
            asm volatile("s_waitcnt lgkmcnt(0)" ::: "memory"); __builtin_amdgcn_s_barrier(); asm volatile("" ::: "memory");
            const int t = (wr * 4 + wc) * 64 + fq * 16 + fr;
            if (t < 256) { const f32x4 v = *(const PG8_LAS f32x4*)(stg + t * 4); sspn[(size_t)(u.pm * BM + t) * 8 + u.pn] = (v[0] + v[1]) + (v[2] + v[3]); }
        }
    }
};
template <class Epi, class Sched, bool ALIGN_EPI = false, bool SP2 = false>
__device__ __forceinline__ void gemm_phase(PG8_LAS unsigned char* lds, const Gemm g, const Sched& S, const Epi& E, int wv  ) {
    int lane_; asm volatile("v_mbcnt_lo_u32_b32 %0, -1, 0\n\tv_mbcnt_hi_u32_b32 %0, -1, %0" : "=v"(lane_));
    asm volatile("" : "+s"(wv));
    const int tid = wv * 64 + lane_, wid = wv, lane = tid & 63, wr = wid >> 2, wc = wid & 3, fr = lane & 15, fq = lane >> 4;
    const int K = g.K, nt = K / BK;
    unsigned voffA[2], voffB[2];
#pragma unroll
    for (int i = 0; i < 2; ++i) { int R, C; stage_rc(tid * 16 + i * 8192, R, C); const int Rb = Epi::PERM ? ((R & ~31) + perm32(R & 31)) : R;
        voffA[i] = (unsigned)(R * K + C) * 2u; voffB[i] = (unsigned)(Rb * K + C) * 2u; }
    const size_t kstep = (size_t)(BK * 2);
    const size_t hstep = (size_t)HALF * K * 2;
    const size_t tstep = 2 * hstep;
    const unsigned ldsw = (unsigned)wid * 1024u;
    const int aoff = lds_byte(wr * 64 + fr, fq * 8), boff = lds_byte(wc * 32 + fr, fq * 8);
#define PG8_SA(b, h) (((b) * 2 + (h)) * HTB)
#define PG8_SB(b, h) ((4 + (b) * 2 + (h)) * HTB)
#define PG8_STAGE(bufoff, gbase, voff) do { _Pragma("unroll") for (int _i = 0; _i < 2; ++_i) \
        __builtin_amdgcn_global_load_lds((const unsigned*)((const char*)(gbase) + (voff)[_i]), (PG8_LAS unsigned*)(lds + (bufoff) + ldsw + _i * 8192), 16, 0, 0); } while (0)
#define PG8_LDA(dst, b, h) do { _Pragma("unroll") for (int m = 0; m < 4; ++m) _Pragma("unroll") for (int k = 0; k < 2; ++k) dst[m][k] = *(const PG8_LAS bf16x8*)(lds + PG8_SA(b, h) + aoff + m * 2048 + k * 1024); } while (0)
#define PG8_LDB(dst, b, h) do { _Pragma("unroll") for (int n = 0; n < 2; ++n) _Pragma("unroll") for (int k = 0; k < 2; ++k) dst[n][k] = *(const PG8_LAS bf16x8*)(lds + PG8_SB(b, h) + boff + n * 2048 + k * 1024); } while (0)
#define PG8_MMA(ai, bj, At, Bt) do { __builtin_amdgcn_s_setprio(1); _Pragma("unroll") for (int m = 0; m < 4; ++m) _Pragma("unroll") for (int n = 0; n < 2; ++n) _Pragma("unroll") for (int k = 0; k < 2; ++k) \
        acc[ai][bj][m][n] = __builtin_amdgcn_mfma_f32_16x16x32_bf16(Bt[n][k], At[m][k], acc[ai][bj][m][n], 0, 0, 0); __builtin_amdgcn_s_setprio(0); } while (0)
#define PG8_WAIT_V(n) asm volatile("s_waitcnt vmcnt(" #n ")" ::: "memory")
#define PG8_WAIT_V8_NZ(t) asm volatile("s_cmp_eq_u32 %0, 0\n\ts_cbranch_scc1 1f\n\ts_waitcnt vmcnt(8)\n1:" :: "s"(t) : "scc", "memory")
#define PG8_WAIT_L(n) asm volatile("s_waitcnt lgkmcnt(" #n ")" ::: "memory")
#define PG8_BAR __builtin_amdgcn_s_barrier()
#define PG8_SCHED __builtin_amdgcn_sched_barrier(0)
    Unit cur, nxt; int ui = 0;
    if (!S.next(0, cur)) return;
    { const typename Epi::Pre pr0 = E.prep_load(cur, tid); E.prep_commit(pr0, tid); } asm volatile("s_waitcnt lgkmcnt(0)" ::: "memory"); PG8_BAR; asm volatile("" ::: "memory");
    f32x4 acc[2][2][4][2];
#pragma unroll
    for (int a = 0; a < 2; ++a)
#pragma unroll
        for (int b = 0; b < 2; ++b)
#pragma unroll
            for (int m = 0; m < 4; ++m)
#pragma unroll
                for (int n = 0; n < 2; ++n) acc[a][b][m][n] = (f32x4){0.f, 0.f, 0.f, 0.f};
    bf16x8 At[4][2], B0[2][2], B1[2][2];
    const char* cA = (const char*)g.A + (size_t)cur.pm * tstep; const char* cB = (const char*)g.Bt + (size_t)cur.pn * tstep;
    S.a_ready(cur);
    if constexpr (SP2) {
        PG8_STAGE(PG8_SB(0, 0), cB, voffB); PG8_STAGE(PG8_SB(0, 1), cB + hstep, voffB); PG8_STAGE(PG8_SA(0, 0), cA, voffA); PG8_STAGE(PG8_SA(0, 1), cA + hstep, voffA);
        PG8_STAGE(PG8_SB(1, 0), cB + kstep, voffB); PG8_STAGE(PG8_SA(1, 0), cA + kstep, voffA); PG8_STAGE(PG8_SB(1, 1), cB + hstep + kstep, voffB); PG8_STAGE(PG8_SA(1, 1), cA + hstep + kstep, voffA);
        if (wr == 1) PG8_BAR;
        PG8_WAIT_V(0); PG8_BAR;
        PG8_BAR;
    } else {
        PG8_STAGE(PG8_SB(0, 0), cB, voffB); PG8_STAGE(PG8_SA(0, 0), cA, voffA); PG8_STAGE(PG8_SB(0, 1), cB + hstep, voffB); PG8_STAGE(PG8_SA(0, 1), cA + hstep, voffA);
        if (wr == 1) PG8_BAR;
        PG8_WAIT_V(4); PG8_BAR;
        PG8_STAGE(PG8_SB(1, 0), cB + kstep, voffB); PG8_STAGE(PG8_SA(1, 0), cA + kstep, voffA); PG8_STAGE(PG8_SB(1, 1), cB + hstep + kstep, voffB);
        PG8_WAIT_V(6); PG8_BAR;
    }
    for (;;) {
        const bool has_next = S.next(ui + 1, nxt);
        const char* nA = has_next ? (const char*)g.A + (size_t)nxt.pm * tstep : cA; const char* nB = has_next ? (const char*)g.Bt + (size_t)nxt.pn * tstep : cB;
        for (int t = 0; t < nt; t += 2) {
            const bool last = (t == nt - 2);
            if (E.has_midk() && t == (nt >> 1)) E.midk(acc, cur, wr, fr);
            const char* a1 = cA + (size_t)(t + 1) * kstep;
            const char* a2 = last ? nA : cA + (size_t)(t + 2) * kstep; const char* b2 = last ? nB : cB + (size_t)(t + 2) * kstep;
            const char* a3 = a2 + kstep; const char* b3 = b2 + kstep;
            if (last && has_next) S.a_ready(nxt);
            if constexpr (SP2) {
            PG8_LDB(B0, 0, 0); PG8_LDB(B1, 0, 1); PG8_SCHED; PG8_LDA(At, 0, 0); PG8_STAGE(PG8_SA(1, 1), a1 + hstep, voffA);
            PG8_WAIT_V8_NZ(t); PG8_WAIT_L(0); PG8_BAR; PG8_MMA(0, 0, At, B0); PG8_MMA(0, 1, At, B1); PG8_BAR; PG8_SCHED;
            PG8_LDA(At, 0, 1); PG8_STAGE(PG8_SB(0, 0), b2, voffB); PG8_STAGE(PG8_SB(0, 1), b2 + hstep, voffB); PG8_STAGE(PG8_SA(0, 0), a2, voffA);
            PG8_WAIT_V8_NZ(t); PG8_WAIT_L(0); PG8_BAR; PG8_MMA(1, 0, At, B0); PG8_MMA(1, 1, At, B1); PG8_BAR; PG8_SCHED;
            PG8_LDB(B0, 1, 0); PG8_LDB(B1, 1, 1); PG8_SCHED; PG8_LDA(At, 1, 0); PG8_STAGE(PG8_SA(0, 1), a2 + hstep, voffA);
            PG8_WAIT_V8_NZ(t); PG8_WAIT_L(0); PG8_BAR; PG8_MMA(0, 0, At, B0); PG8_MMA(0, 1, At, B1); PG8_BAR; PG8_SCHED;
            PG8_LDA(At, 1, 1); PG8_STAGE(PG8_SB(1, 0), b3, voffB); PG8_STAGE(PG8_SB(1, 1), b3 + hstep, voffB); PG8_STAGE(PG8_SA(1, 0), a3, voffA);
            PG8_WAIT_V(8); PG8_WAIT_L(0); PG8_BAR; PG8_MMA(1, 0, At, B0); PG8_MMA(1, 1, At, B1); PG8_BAR; PG8_SCHED;
            } else {
            PG8_LDB(B0, 0, 0); PG8_SCHED; PG8_LDA(At, 0, 0); PG8_STAGE(PG8_SA(1, 1), a1 + hstep, voffA);
            PG8_WAIT_L(8); PG8_BAR; PG8_WAIT_L(0); PG8_MMA(0, 0, At, B0); PG8_BAR; PG8_SCHED;
            PG8_LDB(B1, 0, 1); PG8_STAGE(PG8_SB(0, 0), b2, voffB);
            PG8_BAR; PG8_WAIT_L(0); PG8_MMA(0, 1, At, B1); PG8_BAR;
            PG8_LDA(At, 0, 1); PG8_STAGE(PG8_SA(0, 0), a2, voffA);
            PG8_BAR; PG8_WAIT_L(0); PG8_MMA(1, 0, At, B0); PG8_BAR; PG8_SCHED;
            PG8_STAGE(PG8_SB(0, 1), b2 + hstep, voffB);
            PG8_WAIT_V(6); PG8_BAR; PG8_MMA(1, 1, At, B1); PG8_BAR;
            PG8_LDB(B0, 1, 0); PG8_SCHED; PG8_LDA(At, 1, 0); PG8_STAGE(PG8_SA(0, 1), a2 + hstep, voffA);
            PG8_WAIT_L(8); PG8_BAR; PG8_WAIT_L(0); PG8_MMA(0, 0, At, B0); PG8_BAR; PG8_SCHED;
            PG8_LDB(B1, 1, 1); PG8_STAGE(PG8_SB(1, 0), b3, voffB);
            PG8_BAR; PG8_WAIT_L(0); PG8_MMA(0, 1, At, B1); PG8_BAR;
            PG8_LDA(At, 1, 1); PG8_STAGE(PG8_SA(1, 0), a3, voffA);
            PG8_BAR; PG8_WAIT_L(0); PG8_MMA(1, 0, At, B0); PG8_BAR; PG8_SCHED;
            PG8_STAGE(PG8_SB(1, 1), b3 + hstep, voffB);
            PG8_WAIT_V(6); PG8_BAR; PG8_MMA(1, 1, At, B1); PG8_BAR;
            }
        }
        if constexpr (ALIGN_EPI) { if (wr == 0) PG8_BAR; }
        if constexpr (SP2) { if (has_next) PG8_STAGE(PG8_SA(1, 1), nA + kstep + hstep, voffA); } asm volatile("" ::: "memory");
        if constexpr (!Epi::AFTER_DRAIN) {
            typename Epi::Pre prn; if (has_next) { int ln_; asm volatile("v_mbcnt_lo_u32_b32 %0, -1, 0\n\tv_mbcnt_hi_u32_b32 %0, -1, %0" : "=v"(ln_)); prn = E.prep_load(nxt, wid * 64 + ln_); }
            asm volatile("" ::: "memory");
            E(acc, cur, wr, wc, fr, fq); S.done(cur);
            if constexpr (ALIGN_EPI) { if (has_next) { asm volatile("s_waitcnt lgkmcnt(0)" ::: "memory"); PG8_BAR; asm volatile("" ::: "memory"); { int ln_; asm volatile("v_mbcnt_lo_u32_b32 %0, -1, 0\n\tv_mbcnt_hi_u32_b32 %0, -1, %0" : "=v"(ln_)); E.prep_commit(prn, wid * 64 + ln_); } asm volatile("s_waitcnt lgkmcnt(0)" ::: "memory"); } } }
        if (!has_next) break;
#pragma unroll
        for (int a = 0; a < 2; ++a)
#pragma unroll
            for (int b = 0; b < 2; ++b)
#pragma unroll
                for (int m = 0; m < 4; ++m)
#pragma unroll
                    for (int n = 0; n < 2; ++n) acc[a][b][m][n] = (f32x4){0.f, 0.f, 0.f, 0.f};
        cur = nxt; cA = nA; cB = nB; ++ui;
        if constexpr (ALIGN_EPI) { if (wr == 1) PG8_BAR; }
    }
    PG8_WAIT_V(0);
    if constexpr (!ALIGN_EPI) { if (wr == 0) PG8_BAR; }
    PG8_BAR;
    if constexpr (Epi::AFTER_DRAIN) { E.fused(acc, cur, wr, wc, fr, fq, lds, wid, lane); S.done(cur); }
#undef PG8_SA
#undef PG8_SB
#undef PG8_STAGE
#undef PG8_LDA
#undef PG8_LDB
#undef PG8_MMA
#undef PG8_WAIT_V
#undef PG8_WAIT_V8_NZ
#undef PG8_WAIT_L
#undef PG8_BAR
#undef PG8_SCHED
}
}
namespace att {
#define ATT_DEFER_L 0
using bf16 = __hip_bfloat16;
constexpr int   D = 128, NW = 8, QBLK = 32, KVBLK = 64;
constexpr float SCALE = 0.088388347648318440f;
constexpr float LOG2E = 1.4426950408889634f;
constexpr int LDQ = 3072, LDK = 3072, LDO = 2048;
constexpr size_t SHM_V = KVBLK * D * 2, SHM_K = KVBLK * D * 2, SHM_ATTN = 2 * SHM_V + 2 * SHM_K + NW * 64 * 4;

using bf16x8 = __attribute__((ext_vector_type(8))) short;
using s16x4  = __attribute__((ext_vector_type(4))) short;
using f32x16 = __attribute__((ext_vector_type(16))) float;
using u32x4  = __attribute__((ext_vector_type(4))) unsigned;
using f32x4v = __attribute__((ext_vector_type(4))) float;
typedef __attribute__((address_space(3))) char* lds_ptr;
typedef __attribute__((address_space(3))) const char* lds_cptr;
#define KSWZ(row, colB) ((row) * 256 + ((colB) ^ (((row) & 7) << 4)))
#define SBAR() __builtin_amdgcn_sched_barrier(0)
__device__ __forceinline__ int crow(int r, int hi) { return (r & 3) + 8 * (r >> 2) + 4 * hi; }
__device__ __forceinline__ unsigned cvtpk(float lo, float hi) { unsigned r; asm volatile("v_cvt_pk_bf16_f32 %0, %1, %2" : "=v"(r) : "v"(lo), "v"(hi)); return r; }
__device__ __forceinline__ bf16x8 ld8(const bf16* p) { return *reinterpret_cast<const bf16x8*>(p); }

__device__ __forceinline__ float fadd_s(float a, float b) { float r; asm("v_add_f32_e32 %0, %1, %2" : "=v"(r) : "v"(a), "v"(b)); return r; }
typedef short v4i16_t __attribute__((ext_vector_type(4)));
__device__ __forceinline__ s16x4 vtr(const __attribute__((address_space(3))) char* p) { return __builtin_bit_cast(s16x4, __builtin_amdgcn_ds_read_tr16_b64_v4i16((__attribute__((address_space(3))) v4i16_t*)p)); }
__device__ __forceinline__ float rowmax32(const f32x16& p0, const f32x16& p1) {
  float a = fmaxf(fmaxf(p0[0], p0[1]), p1[0]), b = fmaxf(fmaxf(p0[2], p0[3]), p1[1]); a = fmaxf(fmaxf(a, p1[2]), p1[3]);
#pragma unroll
  for (int r = 4; r < 16; r += 4) { a = fmaxf(fmaxf(a, p0[r]), p0[r + 1]); b = fmaxf(fmaxf(b, p0[r + 2]), p0[r + 3]); a = fmaxf(fmaxf(a, p1[r]), p1[r + 1]); b = fmaxf(fmaxf(b, p1[r + 2]), p1[r + 3]); }
  float m = fmaxf(a, b);
  auto rr = __builtin_amdgcn_permlane32_swap(__float_as_uint(m), __float_as_uint(m), false, false);
  return fmaxf(__uint_as_float(rr[0]), __uint_as_float(rr[1]));
}
__device__ __forceinline__ void psm_start(f32x16& p0, f32x16& p1, f32x16& negm, float& mref) {
  const float pm = rowmax32(p0, p1); const float d = pm > -1e30f ? pm : 0.f;
  mref = d;
#pragma unroll
  for (int r = 0; r < 16; ++r) { p0[r] -= d; p1[r] -= d; negm[r] = -d; }
  asm volatile("" : "+v"(negm));
#pragma unroll
  for (int r = 0; r < 16; ++r) p0[r] = __builtin_amdgcn_exp2f(p0[r]);
}
__device__ __forceinline__ void psm_next(f32x16& p0, f32x16& p1, f32x16& negm, float& mref, float& alpha) {
  constexpr float THR2 = 11.0f;
  const float pm = rowmax32(p0, p1);
  if (__builtin_expect(__all(pm <= THR2), 1)) { alpha = 1.f; }
  else { const float d = fmaxf(pm, 0.f); mref += d; alpha = __builtin_amdgcn_exp2f(-d);
#pragma unroll
    for (int r = 0; r < 16; ++r) { p0[r] -= d; p1[r] -= d; negm[r] = -mref; }
    asm volatile("" : "+v"(negm)); }
#pragma unroll
  for (int r = 0; r < 16; ++r) p0[r] = __builtin_amdgcn_exp2f(p0[r]);
}
constexpr int WLUT_OFF = 146048, WCOPY = 456, WTAB_BYTES = 4 * WCOPY * 4, WLUT_STRIDE = 260, WROWS = 128;
__device__ __forceinline__ void win_bias_tab(f32x16& p0, f32x16& p1, int dq, lds_cptr tab, int hi) {
  const int e0 = dq + 4 * hi + 224, s = e0 & 3;
  const lds_cptr a = tab + s * (WCOPY * 4) + (e0 - s) * 4;
#pragma unroll
  for (int g = 0; g < 4; ++g) { const f32x4v b0 = *(const __attribute__((address_space(3))) f32x4v*)(a + 32 * g), b1 = *(const __attribute__((address_space(3))) f32x4v*)(a + 128 + 32 * g);
#pragma unroll
    for (int j = 0; j < 4; ++j) { p0[4 * g + j] += b0[j]; p1[4 * g + j] += b1[j]; } }
}
template <bool NOPERM  >
__device__ __forceinline__ void finishSM(f32x16& p0, f32x16& p1, float alpha, float& l_reg, bf16x8& pa0, bf16x8& pa1, bf16x8& pa2, bf16x8& pa3) {
  for (int r = 0; r < 16; ++r) p1[r] = __builtin_amdgcn_exp2f(p1[r]);
  typedef float f2_t __attribute__((ext_vector_type(2)));
  f2_t s2 = (f2_t){p0[0], p0[1]} + (f2_t){p1[0], p1[1]};
#pragma unroll
  for (int r = 2; r < 16; r += 2) { s2 += (f2_t){p0[r], p0[r + 1]}; s2 += (f2_t){p1[r], p1[r + 1]}; }
  float ps = s2.x + s2.y;
  if constexpr (!NOPERM || !ATT_DEFER_L) { auto rr = __builtin_amdgcn_permlane32_swap(__float_as_uint(ps), __float_as_uint(ps), false, false); ps = __uint_as_float(rr[0]) + __uint_as_float(rr[1]); }
  l_reg = l_reg * alpha + ps;
#define PK4(P, BASE, OUT) do { if constexpr (NOPERM) { u32x4 w = {cvtpk(P[BASE + 0], P[BASE + 1]), cvtpk(P[BASE + 2], P[BASE + 3]), cvtpk(P[BASE + 4], P[BASE + 5]), cvtpk(P[BASE + 6], P[BASE + 7])}; OUT = *reinterpret_cast<bf16x8*>(&w); } \
    else { unsigned a0 = cvtpk(P[BASE + 0], P[BASE + 1]), a1 = cvtpk(P[BASE + 2], P[BASE + 3]); unsigned b0 = cvtpk(P[BASE + 4], P[BASE + 5]), b1 = cvtpk(P[BASE + 6], P[BASE + 7]); \
      auto r0 = __builtin_amdgcn_permlane32_swap(a0, b0, false, false); auto r1 = __builtin_amdgcn_permlane32_swap(a1, b1, false, false); \
      u32x4 w = {r0[0], r1[0], r0[1], r1[1]}; OUT = *reinterpret_cast<bf16x8*>(&w); } } while (0)
  PK4(p0, 0, pa0); asm volatile("" : "+v"(pa0)); PK4(p0, 8, pa1); asm volatile("" : "+v"(pa1)); PK4(p1, 0, pa2); asm volatile("" : "+v"(pa2)); PK4(p1, 8, pa3); asm volatile("" : "+v"(pa3));
#undef PK4
}
__device__ __forceinline__ void qkt(f32x16& p0, f32x16& p1, const bf16* Ks, const bf16x8* qr, int r32, int hi) {
  p0 = f32x16{}; p1 = f32x16{};
  for (int d0 = 0; d0 < 8; ++d0) { int cb = (d0 * 16 + hi * 8) * 2;
    bf16x8 b0 = *reinterpret_cast<const bf16x8*>((const char*)Ks + KSWZ(r32, cb));
    bf16x8 b1 = *reinterpret_cast<const bf16x8*>((const char*)Ks + KSWZ(32 + r32, cb));
    p0 = __builtin_amdgcn_mfma_f32_32x32x16_bf16(b0, qr[d0], p0, 0, 0, 0);
    p1 = __builtin_amdgcn_mfma_f32_32x32x16_bf16(b1, qr[d0], p1, 0, 0, 0); }
}
__device__ __forceinline__ int v_st(int k, int c) { const int kk = (k & ~0xC) | ((k & 4) << 1) | ((k & 8) >> 1); return ((kk >> 3) * 4 + (c >> 5)) * 512 + ((kk & 7) * 32 + (c & 31)) * 2; }
__device__ __forceinline__ int v_rd_base(int lane) { return ((lane & 3) << 3) | (((lane >> 2) & 3) << 6) | (((lane >> 4) & 1) << 5) | (((lane >> 5) & 1) << 8); }
constexpr int v_rd_off(int d0, int ks, int half) { return d0 * 512 + ks * 4096 + half * 2048; }
template <int OFF> __device__ __forceinline__ void k_rda(bf16x8& f, int addr) { asm volatile("ds_read_b128 %0, %1 offset:%2" : "=v"(f) : "v"(addr), "n"(OFF)); }
template <int N> __device__ __forceinline__ void k_wt(bf16x8& f) { asm volatile("s_waitcnt lgkmcnt(%1)" : "+v"(f) : "n"(N)); }
template <int N> __device__ __forceinline__ void v_wt(s16x4& l, s16x4& h) { asm volatile("s_waitcnt lgkmcnt(%2)" : "+v"(l), "+v"(h) : "n"(N)); }
template <int OFF> __device__ __forceinline__ s16x4 tr_read(int vb) {
  s16x4 r; asm volatile("ds_read_b64_tr_b16 %0, %1 offset:%2" : "=&v"(r) : "v"(vb), "i"(OFF) : "memory"); return r;
}
template <int KS> __device__ __forceinline__ void pv_ks(f32x16* o, int vb, bf16x8 pa) {
  const s16x4 l0 = tr_read<v_rd_off(0, KS, 0)>(vb), h0 = tr_read<v_rd_off(0, KS, 1)>(vb), l1 = tr_read<v_rd_off(1, KS, 0)>(vb), h1 = tr_read<v_rd_off(1, KS, 1)>(vb);
  const s16x4 l2 = tr_read<v_rd_off(2, KS, 0)>(vb), h2 = tr_read<v_rd_off(2, KS, 1)>(vb), l3 = tr_read<v_rd_off(3, KS, 0)>(vb), h3 = tr_read<v_rd_off(3, KS, 1)>(vb);
  asm volatile("s_waitcnt lgkmcnt(0)" ::: "memory"); SBAR();
#define PK(L, H) (bf16x8){L[0], L[1], L[2], L[3], H[0], H[1], H[2], H[3]}
  o[0] = __builtin_amdgcn_mfma_f32_32x32x16_bf16(pa, PK(l0, h0), o[0], 0, 0, 0);
  o[1] = __builtin_amdgcn_mfma_f32_32x32x16_bf16(pa, PK(l1, h1), o[1], 0, 0, 0);
  o[2] = __builtin_amdgcn_mfma_f32_32x32x16_bf16(pa, PK(l2, h2), o[2], 0, 0, 0);
  o[3] = __builtin_amdgcn_mfma_f32_32x32x16_bf16(pa, PK(l3, h3), o[3], 0, 0, 0);
#undef PK
}
__device__ __forceinline__ void pv_d0(f32x16* o, int vb, bf16x8 pa0, bf16x8 pa1, bf16x8 pa2, bf16x8 pa3) {
  pv_ks<0>(o, vb, pa0); pv_ks<1>(o, vb, pa1); pv_ks<2>(o, vb, pa2); pv_ks<3>(o, vb, pa3);
}
constexpr int RING_SLOT = 16384, RING_V = 65536;
template <bool ZC  >
__device__ __forceinline__ void qkt_l(f32x16& p0, f32x16& p1, const lds_cptr* kb4, int koff, const bf16x8* qr, const f32x16& negm) {
#pragma unroll
  for (int d0 = 0; d0 < 8; ++d0) { const lds_cptr a = kb4[d0 & 3] + koff + (d0 >> 2) * 128;
    const bf16x8 b0 = *(const __attribute__((address_space(3))) bf16x8*)(a);
    const bf16x8 b1 = *(const __attribute__((address_space(3))) bf16x8*)(a + 32 * 256);
    p0 = __builtin_amdgcn_mfma_f32_32x32x16_bf16(b0, qr[d0], d0 == 0 ? (ZC ? f32x16{} : negm) : p0, 0, 0, 0);
    p1 = __builtin_amdgcn_mfma_f32_32x32x16_bf16(b1, qr[d0], d0 == 0 ? (ZC ? f32x16{} : negm) : p1, 0, 0, 0); }
}
template <bool WIN, bool DYN>
__device__ __forceinline__ void attn_body(const bf16* __restrict__ Qb, const bf16* __restrict__ Kh, const bf16* __restrict__ Vh,
                                          bf16* __restrict__ Ob, int seq, int P0, const float* lut, float sink2, lds_ptr ring, float* wsbase,
                                          const float* __restrict__ qg, const float* __restrict__ rope, float* sso, int wv, float sbound) {
  static_assert(DYN || !WIN, "the fixed-reference softmax needs bounded scores (normalised q and k)");
  int lane_; asm volatile("v_mbcnt_lo_u32_b32 %0, -1, 0\n\tv_mbcnt_hi_u32_b32 %0, -1, %0" : "=v"(lane_));
  asm volatile("" : "+s"(wv));
  const int wid = wv, lane = lane_, r32 = lane & 31, hi = lane >> 5;
  float* ws = wsbase + wid * 64; float* li_l = ws; float* al_l = ws + 32;
  float mref = 0.f, l_reg = 0; f32x16 o[4] = {}; bf16x8 qr[8]; f32x16 negm = f32x16{}; constexpr bool dyn = DYN;
  (void)sbound;
  asm volatile("" : "+v"(negm));
  const int wrow = WIN ? (wid & 3) : wid, whead = WIN ? (wid >> 2) : 0;
  const bf16* Qw = Qb + (long)(wrow * QBLK + r32) * LDQ + whead * 128 + hi * 8;
#pragma unroll
  for (int d0 = 0; d0 < 8; ++d0) qr[d0] = ld8(Qw + d0 * 16);
  int kb0 = 0, NT = seq / KVBLK;
  if (WIN) { int jlo = P0 / KVBLK - 2; if (jlo < 0) jlo = 0; int jhi = P0 / KVBLK + WROWS / KVBLK + 2; if (jhi > seq / KVBLK) jhi = seq / KVBLK; kb0 = jlo * KVBLK; NT = jhi - jlo; }
  unsigned oK[2], oV[2];
#pragma unroll
  for (int j = 0; j < 2; ++j) { const int q = 2 * wid + j;
    { const int row = 4 * q + (lane >> 4), cc = lane & 15, c = cc ^ (row & 7); oK[j] = (unsigned)(row * LDK + c * 8) * 2u; }
    { const int p = q * 64 + lane, st = p >> 5, pp = p & 31, kk = 8 * (st >> 2) + (pp >> 2), k = DYN ? ((kk & ~0xC) | ((kk & 4) << 1) | ((kk & 8) >> 1)) : kk, c = 32 * (st & 3) + 8 * (pp & 3);
      oV[j] = (unsigned)(k * LDK + c) * 2u; } }
  const char* Kt0 = (const char*)(Kh + (long)kb0 * LDK); const char* Vt0 = (const char*)(Vh + (long)kb0 * LDK);
  const lds_ptr dK = ring + wid * 2048, dV = ring + RING_V + wid * 2048;
#define DMA(t) do { const int sl_ = ((t) & 3) * RING_SLOT; const long go_ = (long)(t) * KVBLK * LDK * 2; const char* kt_ = Kt0 + go_; const char* vt_ = Vt0 + go_; \
    __builtin_amdgcn_global_load_lds((const unsigned*)(kt_ + oK[0]), (__attribute__((address_space(3))) unsigned*)(dK + sl_), 16, 0, 0); \
    __builtin_amdgcn_global_load_lds((const unsigned*)(kt_ + oK[1]), (__attribute__((address_space(3))) unsigned*)(dK + sl_ + 1024), 16, 0, 0); \
    __builtin_amdgcn_global_load_lds((const unsigned*)(vt_ + oV[0]), (__attribute__((address_space(3))) unsigned*)(dV + sl_), 16, 0, 0); \
    __builtin_amdgcn_global_load_lds((const unsigned*)(vt_ + oV[1]), (__attribute__((address_space(3))) unsigned*)(dV + sl_ + 1024), 16, 0, 0); } while (0)
#define DMA1(t, pc) do { const int sl_ = ((t) & 3) * RING_SLOT; const long go_ = (long)(t) * KVBLK * LDK * 2; \
    if ((pc) == 0) __builtin_amdgcn_global_load_lds((const unsigned*)(Kt0 + go_ + oK[0]), (__attribute__((address_space(3))) unsigned*)(dK + sl_), 16, 0, 0); \
    if ((pc) == 1) __builtin_amdgcn_global_load_lds((const unsigned*)(Kt0 + go_ + oK[1]), (__attribute__((address_space(3))) unsigned*)(dK + sl_ + 1024), 16, 0, 0); \
    if ((pc) == 2) __builtin_amdgcn_global_load_lds((const unsigned*)(Vt0 + go_ + oV[0]), (__attribute__((address_space(3))) unsigned*)(dV + sl_), 16, 0, 0); \
    if ((pc) == 3) __builtin_amdgcn_global_load_lds((const unsigned*)(Vt0 + go_ + oV[1]), (__attribute__((address_space(3))) unsigned*)(dV + sl_ + 1024), 16, 0, 0); } while (0)
#define WAIT_BAR(N) asm volatile("s_waitcnt vmcnt(" #N ") lgkmcnt(0)\n\ts_barrier" ::: "memory")
  DMA(0); DMA(1);
  if (!WIN) {
    float qf[8][8]; float ss = 0.f;
#pragma unroll
    for (int d0 = 0; d0 < 8; ++d0)
#pragma unroll
      for (int i = 0; i < 8; ++i) { qf[d0][i] = __uint_as_float(((unsigned)(unsigned short)qr[d0][i]) << 16); ss += qf[d0][i] * qf[d0][i]; }
    { auto rr = __builtin_amdgcn_permlane32_swap(__float_as_uint(ss), __float_as_uint(ss), false, false); ss = __uint_as_float(rr[0]) + __uint_as_float(rr[1]); }
    const float rinv = __builtin_amdgcn_rsqf(ss * (1.f / 128.f) + 1e-6f) * (SCALE * LOG2E);
#pragma unroll
    for (int d0 = 0; d0 < 8; ++d0) { const f32x4v g0 = *(const f32x4v*)(qg + d0 * 16 + hi * 8), g1 = *(const f32x4v*)(qg + d0 * 16 + hi * 8 + 4);
#pragma unroll
      for (int i = 0; i < 4; ++i) { qf[d0][i] *= rinv * g0[i]; qf[d0][4 + i] *= rinv * g1[i]; } }
    const int qp = P0 + wid * QBLK + r32;
#pragma unroll
    for (int seg = 0; seg < 2; ++seg) { const int pos = seg == 0 ? (qp >> 6) : (qp & 63);
#pragma unroll
      for (int dd = 0; dd < 2; ++dd) { const int d0 = seg * 4 + dd; const float* tc = rope + pos * 32 + dd * 16 + hi * 8;
        const f32x4v c0 = *(const f32x4v*)tc, c1 = *(const f32x4v*)(tc + 4), s0 = *(const f32x4v*)(tc + 8192), s1 = *(const f32x4v*)(tc + 8192 + 4);
#pragma unroll
        for (int i = 0; i < 8; ++i) { const float c = i < 4 ? c0[i & 3] : c1[i & 3], s = i < 4 ? s0[i & 3] : s1[i & 3]; const float x1 = qf[d0][i], x2 = qf[d0 + 2][i];
          qf[d0][i] = x1 * c - x2 * s; qf[d0 + 2][i] = x2 * c + x1 * s; } } }
#pragma unroll
    for (int d0 = 0; d0 < 8; ++d0) { u32x4 w = {cvtpk(qf[d0][0], qf[d0][1]), cvtpk(qf[d0][2], qf[d0][3]), cvtpk(qf[d0][4], qf[d0][5]), cvtpk(qf[d0][6], qf[d0][7])}; qr[d0] = *reinterpret_cast<bf16x8*>(&w); }  }
  if (WIN) {
#pragma unroll
    for (int d0 = 0; d0 < 8; ++d0) { float t[8];
#pragma unroll
      for (int i = 0; i < 8; ++i) t[i] = __uint_as_float(((unsigned)(unsigned short)qr[d0][i]) << 16) * (SCALE * LOG2E);
      u32x4 w = {cvtpk(t[0], t[1]), cvtpk(t[2], t[3]), cvtpk(t[4], t[5]), cvtpk(t[6], t[7])}; qr[d0] = *reinterpret_cast<bf16x8*>(&w); } }
  lds_cptr kb4[4];
#pragma unroll
  for (int dd = 0; dd < 4; ++dd) kb4[dd] = (lds_cptr)ring + KSWZ(r32, (dd * 16 + hi * 8) * 2);
  const int vb0 = (int)(unsigned)(uintptr_t)(ring + RING_V) + v_rd_base(lane);
  const int qpos = P0 + wrow * QBLK + r32;
#define RESC(a) do { if ((WIN || dyn) && __any((a) < 1.f)) { if (hi == 0) al_l[r32] = (a); asm volatile("s_waitcnt lgkmcnt(0)" ::: "memory"); \
    for (int d = 0; d < 4; ++d) for (int r = 0; r < 16; ++r) o[d][r] *= al_l[crow(r, hi)]; } } while (0)
  const int qlo = P0 + wrow * QBLK;
#define ACT(t) (!WIN || (kb0 + (t) * KVBLK <= qlo + QBLK - 1 + 128 && kb0 + (t) * KVBLK + KVBLK - 1 >= qlo - 128))
#define QKT(PX0, PX1, t) do { if (ACT(t)) qkt_l<!DYN>(PX0, PX1, kb4, ((t) & 3) * RING_SLOT, qr, negm); } while (0)
#define PSM(P0_, P1_, mnX, alX, t) do { if (WIN) { if (ACT(t)) win_bias_tab(P0_, P1_, kb0 + (t) * KVBLK - qpos, (lds_cptr)ring + WLUT_OFF + whead * WTAB_BYTES, hi); } if (WIN || dyn) { if (ACT(t)) psm_next(P0_, P1_, negm, mref, alX); else alX = 1.f; } else { alX = 1.f; unsigned op_; asm volatile("s_mov_b32 %0, 1" : "=s"(op_)); if (op_) { _Pragma("unroll") for (int r_ = 0; r_ < 16; ++r_) P0_[r_] = __builtin_amdgcn_exp2f(P0_[r_]); } } } while (0)
  f32x16 pA0, pA1, pB0, pB1; float mnA, mnB, alA, alB; bf16x8 pa0, pa1, pa2, pa3;
  if (WIN) {
    __attribute__((address_space(3))) float* tw = (__attribute__((address_space(3))) float*)(ring + WLUT_OFF);
    for (int q = wid * 64 + lane; q < 2 * 4 * WCOPY; q += 512) { const int t_ = q / (4 * WCOPY), qq_ = q - t_ * (4 * WCOPY), s_ = qq_ / WCOPY, i_ = qq_ - s_ * WCOPY + s_ - 96; tw[q] = (unsigned)i_ <= 256u ? lut[t_ * WLUT_STRIDE + i_] : -__builtin_inff(); } }
  WAIT_BAR(4);
  SBAR(); QKT(pA0, pA1, 0); if (WIN) { if (ACT(0)) win_bias_tab(pA0, pA1, kb0 - qpos, (lds_cptr)ring + WLUT_OFF + whead * WTAB_BYTES, hi); } if (WIN || dyn) { if (ACT(0)) psm_start(pA0, pA1, negm, mref); } else { _Pragma("unroll") for (int r_ = 0; r_ < 16; ++r_) pA0[r_] = __builtin_amdgcn_exp2f(pA0[r_]); } alA = 1.f;
  if (2 < NT) { DMA(2); WAIT_BAR(4); } else { WAIT_BAR(0); }
#define HALF_STEP(PX0, PX1, mnX, alX, PY0, PY1, alY, t) do { \
    if ((t) + 2 < NT) DMA((t) + 2); \
    SBAR(); QKT(PX0, PX1, t); \
    if (ACT((t) - 1)) { finishSM<!DYN>(PY0, PY1, alY, l_reg, pa0, pa1, pa2, pa3); SBAR(); \
      pv_d0(o, vb0 + (((t) - 1) & 3) * RING_SLOT, pa0, pa1, pa2, pa3); } PSM(PX0, PX1, mnX, alX, t); \
    RESC(alX); \
    if ((t) + 2 < NT) WAIT_BAR(4); else WAIT_BAR(0); } while (0)
  typedef float f2_t __attribute__((ext_vector_type(2)));
#define KLD(i, koff_) do { if (((i) & 1) == 0) { if (((i) >> 3) == 0) k_rda<0>(kf[(i) & 3], ka_[((i) >> 1) & 3]); else k_rda<128>(kf[(i) & 3], ka_[((i) >> 1) & 3]); } \
                           else { if (((i) >> 3) == 0) k_rda<8192>(kf[(i) & 3], ka_[((i) >> 1) & 3]); else k_rda<8320>(kf[(i) & 3], ka_[((i) >> 1) & 3]); } } while (0)
#define VLD(j, vp_) do { vlo[(j) & 3] = tr_read<v_rd_off((j) & 3, (j) >> 2, 0)>(vp_); vhi[(j) & 3] = tr_read<v_rd_off((j) & 3, (j) >> 2, 1)>(vp_); } while (0)
#define VFR(j) (bf16x8){vlo[(j) & 3][0], vlo[(j) & 3][1], vlo[(j) & 3][2], vlo[(j) & 3][3], vhi[(j) & 3][0], vhi[(j) & 3][1], vhi[(j) & 3][2], vhi[(j) & 3][3]}
#define KWAIT(i) do { if ((i) <= 12) k_wt<3>(kf[(i) & 3]); else if ((i) == 13) k_wt<4>(kf[(i) & 3]); else if ((i) == 14) k_wt<5>(kf[(i) & 3]); else k_wt<6>(kf[(i) & 3]); } while (0)
#define VWAIT(j) do { if ((j) <= 12) v_wt<6>(vlo[(j) & 3], vhi[(j) & 3]); else if ((j) == 13) v_wt<4>(vlo[(j) & 3], vhi[(j) & 3]); else if ((j) == 14) v_wt<2>(vlo[(j) & 3], vhi[(j) & 3]); else v_wt<0>(vlo[(j) & 3], vhi[(j) & 3]); } while (0)
#define G1(i, X, Y0_, Y1_, koff_, vp_) do { \
    KWAIT(i); X = __builtin_amdgcn_mfma_f32_32x32x16_bf16(kf[(i) & 3], qr[(i) >> 1], (i) < 2 ? f32x16{} : X, 0, 0, 0); \
    if ((i) + 4 < 16) KLD((i) + 4, koff_); \
    Y1_[i] = __builtin_amdgcn_exp2f(Y1_[i]); \
    sacc = fadd_s(sacc, Y0_[i]); \
    if ((i) < 8) { pw[(i) >> 2][(i) & 3] = cvtpk(Y0_[2 * (i)], Y0_[2 * (i) + 1]); } \
    else { pw[(i) >> 2][(i) & 3] = cvtpk(Y1_[2 * ((i) - 8)], Y1_[2 * ((i) - 8) + 1]); } \
    if ((i) >= 12) VLD((i) - 12, vp_); \
    SBAR(); } while (0)
#define G2(j, X0_, Y1_, vp_, tt) do { \
    VWAIT(j); o[(j) & 3] = __builtin_amdgcn_mfma_f32_32x32x16_bf16(__builtin_bit_cast(bf16x8, pw[(j) >> 2]), VFR(j), o[(j) & 3], 0, 0, 0); \
    if ((j) + 4 < 16) VLD((j) + 4, vp_); \
    X0_[j] = __builtin_amdgcn_exp2f(X0_[j]); asm volatile("" : "+v"(X0_[j])); \
    if ((j) >= 2 && (j) < 6) { if ((tt) + 2 < NT) DMA1((tt) + 2, (j) - 2); } \
    sacc = fadd_s(sacc, Y1_[j]); \
    SBAR(); } while (0)
#define STEP_G(PX0, PX1, PY0, PY1, t) do { \
    const int koff_ = ((t) & 3) * RING_SLOT; const int vp_ = vb0 + (((t) - 1) & 3) * RING_SLOT; int ka_[4]; \
    _Pragma("unroll") for (int dd_ = 0; dd_ < 4; ++dd_) ka_[dd_] = (int)(unsigned)(uintptr_t)kb4[dd_] + koff_; \
    bf16x8 kf[4]; s16x4 vlo[4], vhi[4]; u32x4 pw[4]; float sacc = 0.f; \
    SBAR(); KLD(0, koff_); KLD(1, koff_); KLD(2, koff_); KLD(3, koff_); SBAR(); \
    G1(0, PX0, PY0, PY1, koff_, vp_); G1(1, PX1, PY0, PY1, koff_, vp_); G1(2, PX0, PY0, PY1, koff_, vp_); G1(3, PX1, PY0, PY1, koff_, vp_); \
    G1(4, PX0, PY0, PY1, koff_, vp_); G1(5, PX1, PY0, PY1, koff_, vp_); G1(6, PX0, PY0, PY1, koff_, vp_); G1(7, PX1, PY0, PY1, koff_, vp_); \
    G1(8, PX0, PY0, PY1, koff_, vp_); G1(9, PX1, PY0, PY1, koff_, vp_); G1(10, PX0, PY0, PY1, koff_, vp_); G1(11, PX1, PY0, PY1, koff_, vp_); \
    G1(12, PX0, PY0, PY1, koff_, vp_); G1(13, PX1, PY0, PY1, koff_, vp_); G1(14, PX0, PY0, PY1, koff_, vp_); G1(15, PX1, PY0, PY1, koff_, vp_); \
    G2(0, PX0, PY1, vp_, t); G2(1, PX0, PY1, vp_, t); G2(2, PX0, PY1, vp_, t); G2(3, PX0, PY1, vp_, t); \
    G2(4, PX0, PY1, vp_, t); G2(5, PX0, PY1, vp_, t); G2(6, PX0, PY1, vp_, t); G2(7, PX0, PY1, vp_, t); \
    G2(8, PX0, PY1, vp_, t); G2(9, PX0, PY1, vp_, t); G2(10, PX0, PY1, vp_, t); G2(11, PX0, PY1, vp_, t); \
    G2(12, PX0, PY1, vp_, t); G2(13, PX0, PY1, vp_, t); G2(14, PX0, PY1, vp_, t); G2(15, PX0, PY1, vp_, t); \
    { float ps = sacc; auto rr = __builtin_amdgcn_permlane32_swap(__float_as_uint(ps), __float_as_uint(ps), false, false); l_reg += __uint_as_float(rr[0]) + __uint_as_float(rr[1]); } \
    if ((t) + 2 < NT) WAIT_BAR(4); else WAIT_BAR(0); } while (0)
#pragma nounroll
  for (int j = 1; j + 1 < NT; j += 2) {
    if constexpr (!DYN) { STEP_G(pB0, pB1, pA0, pA1, j); STEP_G(pA0, pA1, pB0, pB1, j + 1); }
    else { HALF_STEP(pB0, pB1, mnB, alB, pA0, pA1, alA, j); HALF_STEP(pA0, pA1, mnA, alA, pB0, pB1, alB, j + 1); }
  }
  SBAR(); QKT(pB0, pB1, NT - 1);
  if (ACT(NT - 2)) { finishSM<!DYN>(pA0, pA1, alA, l_reg, pa0, pa1, pa2, pa3); SBAR();
    pv_d0(o, vb0 + ((NT - 2) & 3) * RING_SLOT, pa0, pa1, pa2, pa3); } PSM(pB0, pB1, mnB, alB, NT - 1);
  RESC(alB);
  if (ACT(NT - 1)) { finishSM<!DYN>(pB0, pB1, alB, l_reg, pa0, pa1, pa2, pa3); SBAR();
    pv_d0(o, vb0 + ((NT - 1) & 3) * RING_SLOT, pa0, pa1, pa2, pa3); }
  if (!DYN && ATT_DEFER_L) { auto rr = __builtin_amdgcn_permlane32_swap(__float_as_uint(l_reg), __float_as_uint(l_reg), false, false); l_reg = __uint_as_float(rr[0]) + __uint_as_float(rr[1]); }
  if (WIN) l_reg += __builtin_amdgcn_exp2f(sink2 - mref);
  if (hi == 0) li_l[r32] = l_reg; asm volatile("s_waitcnt lgkmcnt(0)" ::: "memory");
  float rli[16];
#pragma unroll
  for (int r = 0; r < 16; ++r) rli[r] = __builtin_amdgcn_rcpf(li_l[crow(r, hi)]);
  bf16* Ow = Ob + (long)(wrow * QBLK) * LDO + whead * 128 + (r32 & ~1) + ((r32 & 1) ? 32 : 0);
  const bool odd = (r32 & 1) != 0;
#define DPPF(v, ctrl) __builtin_bit_cast(float, __builtin_amdgcn_mov_dpp(__builtin_bit_cast(int, (v)), (ctrl), 0xF, 0xF, true))
#pragma unroll
  for (int r = 0; r < 16; ++r) { const int orow = crow(r, hi); float sq = 0.f;
#pragma unroll
    for (int dp = 0; dp < 2; ++dp) { const float va = o[2 * dp][r] * rli[r], vb = o[2 * dp + 1][r] * rli[r]; sq += va * va; sq += vb * vb;
      const float x = odd ? va : vb, y = DPPF(x, 0xB1);
      *(unsigned*)(Ow + (long)orow * LDO + dp * 64) = odd ? cvtpk(y, vb) : cvtpk(va, y); }
    sq += DPPF(sq, 0xB1); sq += DPPF(sq, 0x4E); sq += DPPF(sq, 0x141); sq += DPPF(sq, 0x140);
    sq += __builtin_bit_cast(float, __builtin_amdgcn_update_dpp(0, __builtin_bit_cast(int, sq), 0x142, 0xA, 0xF, false));
    if (r32 == 16) sso[16 * (size_t)(wrow * QBLK + orow) + whead] = sq; }
#undef DPPF
  WAIT_BAR(0);
#undef DMA
#undef WAIT_BAR
#undef RESC
#undef PSM
#undef HALF_STEP
#undef STEP_G
#undef G1
#undef G2
#undef KLD
#undef VLD
#undef VFR
#undef KWAIT
#undef VWAIT
#undef DMA1
#undef ACT
#undef QKT
}
#undef KSWZ
#undef SBAR
}
#define GAS __attribute__((address_space(1)))
#define LAS __attribute__((address_space(3)))
typedef unsigned short bf16;
typedef unsigned v4u __attribute__((ext_vector_type(4)));
typedef float f32x4 __attribute__((ext_vector_type(4)));
typedef short bf16x8 __attribute__((ext_vector_type(8)));
typedef GAS unsigned gu32;
typedef GAS unsigned long long gu64;
#define RLX_AGENT __ATOMIC_RELAXED, __HIP_MEMORY_SCOPE_AGENT
#define LDS_WAIT() asm volatile("s_waitcnt lgkmcnt(0)" ::: "memory")
#define VM_WAIT() asm volatile("s_waitcnt vmcnt(0)" ::: "memory")
__device__ __forceinline__ unsigned long long rt() { return __builtin_amdgcn_s_memrealtime(); }
__device__ __forceinline__ unsigned f2bf(float f) { unsigned u = __builtin_bit_cast(unsigned, f); return (u + 0x7fffu + ((u >> 16) & 1u)) >> 16; }
__device__ __forceinline__ unsigned pk2(float lo, float hi) { return f2bf(lo) | (f2bf(hi) << 16); }

#define XB_TMO      128
#define XB_XCNT(j)  (256  + 64 * (j))
#define XB_XSUB(j)  (1280 + 64 * (j))
#define XB_XGEN(j)  (2304 + 64 * (j))
#define XB_TOP      3328
#define XB_TOPGEN   3392
#define XL_SUB(j)   (3456 + 64 * (j))
#define XL_GEN(j)   (4480 + 64 * (j))
#define XCD_BAR_WORDS 5504
#define XB_SPIN_CAP (1u << 18)

__device__ __forceinline__ unsigned xb_ld(unsigned* p)              { return __hip_atomic_load(p, __ATOMIC_RELAXED, __HIP_MEMORY_SCOPE_AGENT); }
__device__ __forceinline__ unsigned xb_add(unsigned* p, unsigned v) { return __hip_atomic_fetch_add(p, v, __ATOMIC_RELAXED, __HIP_MEMORY_SCOPE_AGENT); }
__device__ __forceinline__ unsigned xb_xcc_id() { return (unsigned)__builtin_amdgcn_s_getreg((3 << 11) | 20) & 0xFu; }
#define XB_SPIN(cond, bar) do { unsigned _sp = 0; while (cond) { __builtin_amdgcn_s_sleep(1); \
    if ((++_sp & 255u) == 0u) { if (xb_ld(&(bar)[XB_TMO])) break; if (_sp > XB_SPIN_CAP) { atomicAdd(&(bar)[XB_TMO], 1u); break; } } } } while (0)

__device__ __forceinline__ int lane_now() { int l; asm volatile("v_mbcnt_lo_u32_b32 %0, -1, 0\n\tv_mbcnt_hi_u32_b32 %0, -1, %0" : "=v"(l)); return l; }
struct XcdBarrier {
    unsigned w;
    unsigned* bar; unsigned x;
    volatile LAS unsigned* st;
};

__device__ __forceinline__ XcdBarrier xcd_barrier_post(unsigned* bar, volatile LAS unsigned* st) {
    XcdBarrier b; b.bar = bar; b.x = xb_xcc_id(); b.st = st; b.w = (unsigned)__builtin_amdgcn_readfirstlane((int)threadIdx.x >> 6);
    if (threadIdx.x == 0) st[2] = xb_add(&bar[XB_XCNT(b.x)], 1u);
    return b;
}
__device__ __forceinline__ void xcd_barrier_complete(unsigned* bar, unsigned x, unsigned& nloc, unsigned& nx, unsigned& uni) {
    const unsigned G = gridDim.x * gridDim.y * gridDim.z;
    unsigned sum, cnt, mine, sp = 0u;
    for (;;) {
        sum = 0u; cnt = 0u; mine = 0u;
        unsigned bad = 0u;
#pragma unroll
        for (unsigned j = 0; j < 16; ++j) { const unsigned c = xb_ld(&bar[XB_XCNT(j)]); sum += c; cnt += (c > 0u) ? 1u : 0u; mine = (j == x) ? c : mine; bad |= (j < 8u) ? (unsigned)(c * 8u != G) : (unsigned)(c != 0u); }
        uni = bad ? 0u : 1u;
        if (sum == G) break;
        __builtin_amdgcn_s_sleep(1);
        if ((++sp & 255u) == 0u) { if (xb_ld(&bar[XB_TMO])) break; if (sp > XB_SPIN_CAP) { atomicAdd(&bar[XB_TMO], 1u); break; } }
    }
    nloc = mine > 0u ? mine : 1u; nx = cnt > 0u ? cnt : 1u;
}

__device__ __forceinline__ void xcd_barrier(const XcdBarrier& b) {
    asm volatile("s_waitcnt vmcnt(0)" ::: "memory");
    __syncthreads();
    if (b.w == 0u && lane_now() == 0) {
        unsigned* bar = b.bar;
        __builtin_amdgcn_s_waitcnt(0);
        unsigned nloc = b.st[0], nx = b.st[1];
        if (nloc == 0u) { unsigned uni = 0u; xcd_barrier_complete(bar, b.x, nloc, nx, uni); b.st[0] = nloc; b.st[1] = nx; b.st[3] = uni; }
        const unsigned old = xb_add(&bar[XB_XSUB(b.x)], 1u);
        const unsigned gen = old / nloc;
        if (old + 1u == (gen + 1u) * nloc) {
            __builtin_amdgcn_fence(__ATOMIC_RELEASE, "agent");
            asm volatile("s_waitcnt vmcnt(0)" ::: "memory");
            const unsigned og = xb_add(&bar[XB_TOP], 1u);
            const unsigned tg = og / nx;
            if (og + 1u == (tg + 1u) * nx) xb_add(&bar[XB_TOPGEN], 1u);
            else XB_SPIN(xb_ld(&bar[XB_TOPGEN]) == tg, bar);
            __builtin_amdgcn_fence(__ATOMIC_ACQUIRE, "agent");
            xb_add(&bar[XB_XGEN(b.x)], 1u);
            asm volatile("s_waitcnt vmcnt(0)" ::: "memory");
        } else {
            XB_SPIN(xb_ld(&bar[XB_XGEN(b.x)]) == gen, bar);
            __builtin_amdgcn_fence(__ATOMIC_ACQUIRE, "agent");
            asm volatile("s_waitcnt vmcnt(0)" ::: "memory");
        }
    }
    __syncthreads();
}
__device__ __forceinline__ void xcd_local_barrier(const XcdBarrier& b) {
    asm volatile("s_waitcnt vmcnt(0)" ::: "memory");
    __syncthreads();
    if (b.w == 0u && lane_now() == 0) {
        unsigned* bar = b.bar;
        __builtin_amdgcn_s_waitcnt(0);
        const unsigned nloc = b.st[0];
        const unsigned old = xb_add(&bar[XL_SUB(b.x)], 1u);
        const unsigned gen = old / nloc;
        if (old + 1u == (gen + 1u) * nloc) xb_add(&bar[XL_GEN(b.x)], 1u);
        else XB_SPIN(xb_ld(&bar[XL_GEN(b.x)]) == gen, bar);
        __builtin_amdgcn_fence(__ATOMIC_ACQUIRE, "agent");
        asm volatile("s_waitcnt vmcnt(0)" ::: "memory");
    }
    __syncthreads();
}
#ifndef PG8_SP2
#define PG8_SP2 true
#endif
constexpr int NWAVES = 8;
constexpr int DM = 2048, DEPTH = 4, NIN = 3072, DFF = 8192, MODW = 6 * DM;
constexpr int T0 = 16384, T1 = 8192;
constexpr int M = T0 + 2 * T1;
constexpr float EPS = 1e-6f;
constexpr float LOG2E = 1.4426950408889634f;

constexpr size_t MiB = 1u << 20;
constexpr size_t WS_CTL = 0, CTL_ZERO_BYTES = 128 * 1024;
constexpr size_t WS_MOD = 1 * MiB;
constexpr size_t WS_ROPE = 2 * MiB;
constexpr size_t WS_GV = 3 * MiB;
constexpr size_t WS_BV = 4 * MiB;
constexpr size_t BV_UP = (size_t)DEPTH * 3 * NIN * 4;
constexpr size_t WS_SSP = 6 * MiB;
constexpr size_t WS_SSOP = 10 * MiB;
constexpr size_t WS_W = 12 * MiB, W_LAYER = 84 * MiB;
constexpr size_t W_IN = 0, W_OUT = 12 * MiB, W_UP = 20 * MiB, W_DOWN = 52 * MiB;
constexpr size_t WS_XN = WS_W + DEPTH * W_LAYER;
constexpr size_t WS_QKV = WS_XN + 128 * MiB;
constexpr size_t WS_O = WS_QKV + 192 * MiB;
constexpr size_t WS_H = WS_O + 128 * MiB;
constexpr size_t WS_XB = WS_H + 512 * MiB;
constexpr size_t WS_END = WS_XB + 128 * MiB;
constexpr int CW_BAR = 4096, CW_WQ = 16384;
static_assert((size_t)(CW_BAR + XCD_BAR_WORDS) * 4 <= CTL_ZERO_BYTES && (size_t)(CW_WQ + 64 * 4) * 4 <= CTL_ZERO_BYTES, "every control word lies inside the per-call memset");
static_assert((size_t)M * 8 * 4 <= 4 * MiB && (size_t)M * 16 * 4 <= 2 * MiB && BV_UP + (size_t)DEPTH * 3 * DFF * 4 <= 2 * MiB, "d_ws map");

constexpr int RING_OFF = 0, RING_BYTES = 131072;
constexpr int LDSCTL_OFF = RING_BYTES, MISC_OFF = LDSCTL_OFF + 320;
constexpr int LUT_OFF = LDSCTL_OFF + 512, LUT_STRIDE = 260;
constexpr int TAB_OFF = LUT_OFF + 8 * LUT_STRIDE * 4;
constexpr int AWS_OFF = TAB_OFF + 256 * 8;
constexpr int VEC_OFF = AWS_OFF + 256 * 4 * 4;
constexpr int WLUT_OFF = att::WLUT_OFF;
constexpr int LDS_BYTES = att::WLUT_OFF + 2 * att::WTAB_BYTES;
static_assert(att::WLUT_OFF == VEC_OFF && LUT_STRIDE == att::WLUT_STRIDE && LDS_BYTES <= 163840, "window tables reuse the GEMM epilogues' vector area (idle during the attention phase) and what lies behind it");
static_assert(TAB_OFF % 16 == 0 && AWS_OFF % 16 == 0 && VEC_OFF + 2 * 256 * 4 <= LDS_BYTES, "LDS map");

struct Args { const float* in[19]; float* out; unsigned char* ws; };

__device__ __forceinline__ float wave_sum(float v) {
#define WS_DPP(x, ctrl) __builtin_bit_cast(float, __builtin_amdgcn_mov_dpp(__builtin_bit_cast(int, (x)), (ctrl), 0xF, 0xF, true))
    v += WS_DPP(v, 0xB1); v += WS_DPP(v, 0x4E); v += WS_DPP(v, 0x141); v += WS_DPP(v, 0x140);
#undef WS_DPP
    { auto r = __builtin_amdgcn_permlane16_swap(__float_as_uint(v), __float_as_uint(v), false, false); v = __uint_as_float(r[0]) + __uint_as_float(r[1]); }
    { auto r = __builtin_amdgcn_permlane32_swap(__float_as_uint(v), __float_as_uint(v), false, false); v = __uint_as_float(r[0]) + __uint_as_float(r[1]); }
    return v;
}
__device__ __forceinline__ float bf_lo(unsigned w) { return __builtin_bit_cast(float, w << 16); }
__device__ __forceinline__ float bf_hi(unsigned w) { return __builtin_bit_cast(float, w & 0xffff0000u); }
__device__ __forceinline__ int seq_of_row(int m) { return m < T0 ? 0 : (m < T0 + T1 ? 1 : 2); }
__device__ __forceinline__ int seq_start(int s) { return s == 0 ? 0 : (s == 1 ? T0 : T0 + T1); }

__device__ __forceinline__ void p0_transpose_item(const float* W, int K, int N, bf16* WT, LAS float* scr, int item, int lane, const float* kg) {
    const int nblk = N / 32, kb = item / nblk, nb = item % nblk, k0 = 128 * kb, n0 = 32 * nb;
#pragma unroll
    for (int i = 0; i < 64; ++i) { const int kk = 2 * i + (lane >> 5); const float g = kg ? kg[k0 + kk] : 1.f; scr[kk * 32 + (((lane & 31) + 2 * (kk >> 3)) & 31)] = __builtin_nontemporal_load(W + (size_t)(k0 + kk) * N + n0 + (lane & 31)) * g; }
    LDS_WAIT(); asm volatile("" ::: "memory");
    const int c = lane & 15;
#pragma unroll
    for (int j = 0; j < 8; ++j) { const int n = (lane >> 4) + 4 * j; const LAS float* s = scr + (8 * c) * 32 + ((n + 2 * c) & 31);
        v4u o; o.x = pk2(s[0 * 32], s[1 * 32]); o.y = pk2(s[2 * 32], s[3 * 32]); o.z = pk2(s[4 * 32], s[5 * 32]); o.w = pk2(s[6 * 32], s[7 * 32]);
        *(GAS v4u*)(WT + (size_t)(n0 + n) * K + k0 + 8 * c) = o; }
    LDS_WAIT(); asm volatile("" ::: "memory");
}

template <int IDX> __device__ __forceinline__ const float* kin() {
    unsigned long long v; asm volatile("s_load_dwordx2 %0, %1, %2\n\ts_waitcnt lgkmcnt(0)" : "=s"(v) : "s"(__builtin_amdgcn_kernarg_segment_ptr()), "n"(IDX * 8)); return (const float*)(const GAS float*)v; }
#define KIN(i) kin<(i)>()
#define OUTP() ((float*)kin<19>())
#define WSP() ((unsigned char*)kin<20>())
#define P_SSP() ((float*)(WSP() + WS_SSP))
#define P_SSOP() ((float*)(WSP() + WS_SSOP))
#define P_TAB() ((PG8_LAS pg8::f32x2*)(ldsl + TAB_OFF))
#define P_MOD() ((float*)(WSP() + WS_MOD))
#define P_ROPE() ((float*)(WSP() + WS_ROPE))
#define P_GV(hl) ((float*)(WSP() + WS_GV) + (size_t)(hl) * 3 * DM)
#define P_BV(l, mlp) ((float*)(WSP() + WS_BV + ((mlp) ? BV_UP : 0)) + (size_t)(l) * 3 * ((mlp) ? DFF : NIN))
#define P_XN() ((bf16*)(WSP() + WS_XN))
#define P_QKV() ((bf16*)(WSP() + WS_QKV))
#define P_O() ((bf16*)(WSP() + WS_O))
#define P_H() ((bf16*)(WSP() + WS_H))
#define P_XB() ((bf16*)(WSP() + WS_XB))
template <int BYTE> __device__ __forceinline__ int lds_word_now() { int v; asm volatile("v_mov_b32 %0, %1\n\tds_read_b32 %0, %0\n\ts_waitcnt lgkmcnt(0)" : "=v"(v) : "n"(BYTE) : "memory"); return __builtin_amdgcn_readfirstlane(v); }
#define XL_ON() (lds_word_now<MISC_OFF + 44>() != 0)
#define XL_RANK() lds_word_now<MISC_OFF + 40>()
#define CU_SLOT() (XL_ON() ? (int)bar.x + 8 * XL_RANK() : bx)
#define LAUNDER_LANE() const int lane = lane_now()

__global__ void __launch_bounds__(NWAVES * 64, 2) fwd_kernel(Args args) {
    extern __shared__ __attribute__((aligned(16))) unsigned char lds[];
    LAS unsigned char* ldsl = (LAS unsigned char*)lds;
    volatile LAS unsigned* MISC = (volatile LAS unsigned*)(ldsl + MISC_OFF);
    const int wave = __builtin_amdgcn_readfirstlane((int)threadIdx.x >> 6);
    const int G = gridDim.x; const int bx = blockIdx.x;
    const int vcu = (G % 8 == 0) ? (bx % 8) * (G / 8) + bx / 8 : bx;
    const int gw = vcu * NWAVES + wave, NGW = G * NWAVES;

    for (int u = threadIdx.x; u < (LUT_OFF - LDSCTL_OFF) / 4; u += NWAVES * 64) ((LAS unsigned*)(ldsl + LDSCTL_OFF))[u] = 0u;
    __syncthreads();
    XcdBarrier bar = xcd_barrier_post((unsigned*)((gu32*)(WSP() + WS_CTL) + CW_BAR), MISC + 8);
#define GRID_BAR() do { XcdBarrier b_ = bar; unsigned long long p_ = (unsigned long long)bar.bar; asm volatile("" : "+s"(p_), "+s"(b_.x)); b_.bar = (unsigned*)(GAS unsigned*)p_; xcd_barrier(b_); } while (0)
#define SEAM_BAR(local) do { XcdBarrier b_ = bar; unsigned long long p_ = (unsigned long long)bar.bar; asm volatile("" : "+s"(p_), "+s"(b_.x)); b_.bar = (unsigned*)(GAS unsigned*)p_; if (local) xcd_local_barrier(b_); else xcd_barrier(b_); } while (0)

    {
    {   LAUNDER_LANE(); const int tid = wave * 64 + lane;
        { float* lutw = (float*)(lds + LUT_OFF); const float* rel_bias = KIN(17);
          for (int i = tid; i < 8 * 257; i += NWAVES * 64) { const int h = i / 257, ri = i % 257, rel = ri - 128, n = rel < 0 ? -rel : rel;
              int bk; if (n < 8) bk = n; else { int lg = (31 - __builtin_clz(n * n)) - 6 + 8; bk = lg > 15 ? 15 : lg; }
              if (rel > 0) bk += 16;
              lutw[h * LUT_STRIDE + ri] = rel_bias[bk * 8 + h] * LOG2E; } }
        { const int gid = vcu * (NWAVES * 64) + tid;
          if (gid < 256 * 32) { const int p = gid >> 5, j = gid & 31;
              double f = 1.0; for (int i = 0; i < j; ++i) f *= 0.74989420933245582730;
              const float ang = (float)p * (float)f;
              const double rev = (double)ang * 0.15915494309189533577; const double fr = rev - __builtin_rint(rev); const double xx = fr * 6.28318530717958647693, x2 = xx * xx;
              double sn = 1.0, cs = 1.0;
              for (int k = 14; k >= 1; --k) { sn = 1.0 - sn * x2 / (double)((2 * k) * (2 * k + 1)); cs = 1.0 - cs * x2 / (double)((2 * k - 1) * (2 * k)); }
              P_ROPE()[gid] = (float)cs; P_ROPE()[256 * 32 + gid] = (float)(xx * sn); } }
        { LAS float* scr = (LAS float*)(ldsl + RING_OFF + wave * 16384);
          constexpr int I_IN = (DM / 128) * (NIN / 32), I_OUT = (DM / 128) * (DM / 32), I_UP = (DM / 128) * (DFF / 32), I_DN = (DFF / 128) * (DM / 32), I_L = I_IN + I_OUT + I_UP + I_DN;
          for (int it = gw; it < DEPTH * I_L; it += NGW) { const int l = it / I_L; int r = it % I_L; unsigned char* wl = WSP() + WS_W + (size_t)l * W_LAYER;
              if (r < I_IN) { p0_transpose_item(KIN(7) + (size_t)l * DM * NIN, DM, NIN, (bf16*)(wl + W_IN), scr, r, lane, nullptr); continue; } r -= I_IN;
              if (r < I_OUT) { const int kb = r / (DM / 32);
                  p0_transpose_item(KIN(13) + (size_t)l * DM * DM, DM, DM, (bf16*)(wl + W_OUT), scr, r, lane, kb < 8 ? KIN(11) + l * 1024 : KIN(12) + l * 1024 - 1024); continue; } r -= I_OUT;
              if (r < I_UP) { p0_transpose_item(KIN(15) + (size_t)l * DM * DFF, DM, DFF, (bf16*)(wl + W_UP), scr, r, lane, nullptr); continue; } r -= I_UP;
              p0_transpose_item(KIN(16) + (size_t)l * DFF * DM, DFF, DM, (bf16*)(wl + W_DOWN), scr, r, lane, nullptr); } }
        __syncthreads();
        { float* scv = (float*)lds; float* part = (float*)(lds + 32768); const float* c_prompt = KIN(2); const float* c_sample = KIN(3);
          for (int i = tid; i < 3 * DM; i += NWAVES * 64) { const int s = i / DM, d = i % DM; const float c = s == 0 ? c_prompt[d] : c_sample[(s - 1) * DM + d]; scv[i] = c / (1.f + __expf(-c)); }
          __syncthreads();
          for (int grp = vcu; grp < DEPTH * (MODW / 64); grp += G) { const int l = grp / (MODW / 64), e0 = (grp % (MODW / 64)) * 64;
              const float* w = KIN(4) + (size_t)l * DM * MODW + e0 + lane; float a0 = 0.f, a1 = 0.f, a2 = 0.f; const int d0 = wave * 256;
#pragma unroll 32
              for (int d = d0; d < d0 + 256; ++d) { const float wv = __builtin_nontemporal_load(w + (size_t)d * MODW); a0 = fmaf(scv[d], wv, a0); a1 = fmaf(scv[DM + d], wv, a1); a2 = fmaf(scv[2 * DM + d], wv, a2); }
              part[(wave * 3 + 0) * 64 + lane] = a0; part[(wave * 3 + 1) * 64 + lane] = a1; part[(wave * 3 + 2) * 64 + lane] = a2;
              __syncthreads();
              if (tid < 192) { const int s = tid >> 6, ln = tid & 63, e = e0 + ln; float acc = KIN(5)[l * MODW + e];
#pragma unroll
                  for (int w8 = 0; w8 < 8; ++w8) acc += part[(w8 * 3 + s) * 64 + ln];
                  P_MOD()[(size_t)(l * 3 + s) * MODW + e] = acc;
                  const int chunk = e / DM, k = e % DM;
                  if (chunk == 1) P_GV(2 * l)[s * DM + k] = KIN(6)[l * DM + k] * (1.f + acc);
                  if (chunk == 4) P_GV(2 * l + 1)[s * DM + k] = KIN(14)[l * DM + k] * (1.f + acc); }
              __syncthreads(); } }
    }
    GRID_BAR();
    {   LAUNDER_LANE(); const int tid = wave * 64 + lane;
        float* shv = (float*)lds;
        for (int cb = 0; cb < 2 * DEPTH; ++cb) { const int l = cb >> 1, mlp = cb & 1, N = mlp ? DFF : NIN;
            const float* sh = P_MOD() + (size_t)l * 3 * MODW + (mlp ? 3 * DM : 0);
            for (int i = tid; i < 3 * DM; i += NWAVES * 64) shv[i] = sh[(i / DM) * MODW + (i % DM)];
            __syncthreads();
            const bf16* Wt = (const bf16*)(WSP() + WS_W + (size_t)l * W_LAYER + (mlp ? W_UP : W_IN)); float* bvo = P_BV(l, mlp);
            for (int n0 = gw; n0 < N; n0 += 2 * NGW) {
                v4u w[2][4];
#pragma unroll
                for (int u = 0; u < 2; ++u) { const int n = n0 + u * NGW < N ? n0 + u * NGW : n0;
#pragma unroll
                    for (int j = 0; j < 4; ++j) w[u][j] = *(const v4u*)(Wt + (size_t)n * DM + 8 * lane + 512 * j); }
#pragma unroll
                for (int u = 0; u < 2; ++u) { const int n = n0 + u * NGW; float a0 = 0.f, a1 = 0.f, a2 = 0.f;
#pragma unroll
                    for (int j = 0; j < 4; ++j) { const int k = 8 * lane + 512 * j;
#pragma unroll
                        for (int e = 0; e < 4; ++e) { const float w0 = bf_lo(w[u][j][e]), w1 = bf_hi(w[u][j][e]); const int kk = k + 2 * e;
                            a0 = fmaf(shv[kk], w0, a0); a0 = fmaf(shv[kk + 1], w1, a0); a1 = fmaf(shv[DM + kk], w0, a1); a1 = fmaf(shv[DM + kk + 1], w1, a1);
                            a2 = fmaf(shv[2 * DM + kk], w0, a2); a2 = fmaf(shv[2 * DM + kk + 1], w1, a2); } }
                    a0 = wave_sum(a0); a1 = wave_sum(a1); a2 = wave_sum(a2);
                    if (lane == 0 && n < N) { bvo[n] = a0; bvo[N + n] = a1; bvo[2 * N + n] = a2; } } }
            __syncthreads(); }
        { const float* xb0 = KIN(0); const float* xb1 = KIN(1); const float* gv0 = P_GV(0); bf16* XN = P_XN(); bf16* XB = P_XB(); float* ssp = P_SSP();
          for (int m = gw; m < M; m += NGW) {
              const int s = seq_of_row(m); const float* xr = m < T0 ? xb0 + (size_t)m * DM : xb1 + (size_t)(m - T0) * DM; const float* gv = gv0 + s * DM;
              float ss = 0.f;
#pragma unroll
              for (int j = 0; j < 8; ++j) { const int c = 4 * lane + 256 * j; const f32x4 v = __builtin_nontemporal_load((const f32x4*)(xr + c)); ss += (v.x * v.x + v.y * v.y) + (v.z * v.z + v.w * v.w);
                  const f32x4 o = v * *(const f32x4*)(gv + c);
                  *(unsigned long long*)(XN + (size_t)m * DM + c) = (unsigned long long)pk2(o.x, o.y) | ((unsigned long long)pk2(o.z, o.w) << 32);
                  *(unsigned long long*)(XB + (size_t)m * DM + c) = (unsigned long long)pk2(v.x, v.y) | ((unsigned long long)pk2(v.z, v.w) << 32); }
              ss += __shfl_xor(ss, 32); ss += __shfl_xor(ss, 16); ss += __shfl_xor(ss, 8); if (lane < 8) ssp[(size_t)m * 8 + lane] = ss; } }
    }
    GRID_BAR();

    }
#ifdef PROBE_XL
    if (XL_ON()) for (int i_ = 0; i_ < 1000; ++i_) __builtin_amdgcn_s_sleep(127);
#endif
    for (int hl = 0; hl < 2 * DEPTH; ++hl) {
        const int l = hl >> 1, mlp = hl & 1;
        {   const int N = mlp ? DFF : NIN; const bf16* Bt = (const bf16*)(WSP() + WS_W + (size_t)l * W_LAYER + (mlp ? W_UP : W_IN));
            pg8::Gemm g{P_XN(), Bt, M, N, DM}; pg8::StaticOrder S; S.init(M, N, G, CU_SLOT(), mlp ? 4 : 8);
            pg8::EpiBf16 E{mlp ? P_H() : P_QKV(), N, mlp, P_SSP(), P_BV(l, mlp), P_TAB(), (PG8_LAS float*)(ldsl + VEC_OFF)};
            pg8::gemm_phase<pg8::EpiBf16, pg8::StaticOrder, true, PG8_SP2>(ldsl + RING_OFF, g, S, E, wave);
        }
        SEAM_BAR(XL_ON());
        if (!mlp) {
            {   LAUNDER_LANE();
                bf16* QKV = P_QKV(); const float* ROPE_C = P_ROPE(); const float* ROPE_S = ROPE_C + 256 * 32; const float* kn = KIN(9) + l * 128;
                const int l32 = lane & 31, seg = l32 >> 3; const f32x4 g = *(const f32x4*)(kn + 4 * l32);
                constexpr int T2U = 4;
                const int vcuT = XL_ON() ? (int)bar.x * 32 + XL_RANK() : vcu; const int rowT = (vcuT >> 5) * 4096 + (vcuT & 31) * 8 + wave;
#define DPPF(v, ctrl) __builtin_bit_cast(float, __builtin_amdgcn_mov_dpp(__builtin_bit_cast(int, (v)), (ctrl), 0xF, 0xF, true))
                for (int k0 = 0; k0 < 16; k0 += T2U) {
                    unsigned long long w[T2U]; f32x4 cs[T2U], sn[T2U];
#pragma unroll
                    for (int u = 0; u < T2U; ++u) { const int m = rowT + 256 * (k0 + u), s = seq_of_row(m), t = m - seq_start(s), pos = seg < 2 ? (t >> 6) : (t & 63);
                        w[u] = *(const unsigned long long*)(QKV + (size_t)m * NIN + 1024 + (lane >> 5) * 128 + 4 * l32);
                        cs[u] = *(const f32x4*)(ROPE_C + pos * 32 + 4 * (l32 & 7)); sn[u] = *(const f32x4*)(ROPE_S + pos * 32 + 4 * (l32 & 7)); }
#pragma unroll
                    for (int u = 0; u < T2U; ++u) { const int m = rowT + 256 * (k0 + u); bf16* p = QKV + (size_t)m * NIN + 1024 + (lane >> 5) * 128 + 4 * l32;
                        const unsigned wlo = (unsigned)w[u], whi = (unsigned)(w[u] >> 32);
                        f32x4 v = {bf_lo(wlo), bf_hi(wlo), bf_lo(whi), bf_hi(whi)};
                        float ss = (v.x * v.x + v.y * v.y) + (v.z * v.z + v.w * v.w);
                        ss += DPPF(ss, 0xB1); ss += DPPF(ss, 0x4E); ss += DPPF(ss, 0x141); ss += DPPF(ss, 0x140);
                        { auto r_ = __builtin_amdgcn_permlane16_swap(__float_as_uint(ss), __float_as_uint(ss), false, false); ss = __uint_as_float(r_[0]) + __uint_as_float(r_[1]); }
                        v = v * __builtin_amdgcn_rsqf(ss * (1.f / 128.f) + EPS) * g;
                        f32x4 pn; pn.x = __shfl_xor(v.x, 8); pn.y = __shfl_xor(v.y, 8); pn.z = __shfl_xor(v.z, 8); pn.w = __shfl_xor(v.w, 8);
                        const f32x4 o = (seg & 1) ? v * cs[u] + pn * sn[u] : v * cs[u] - pn * sn[u];
                        *(unsigned long long*)p = (unsigned long long)pk2(o.x, o.y) | ((unsigned long long)pk2(o.z, o.w) << 32); } }
#undef DPPF
            }
            GRID_BAR();
            {   const int vcu2 = XL_ON() ? (int)bar.x * 32 + XL_RANK() : vcu; const int x = vcu2 >> 5, c32 = vcu2 & 31;
                const att::bf16* QKV = (const att::bf16*)P_QKV(); att::bf16* OB = (att::bf16*)P_O(); float* sso = P_SSOP();
                const float* qg = KIN(8) + l * 128; const float* rope = P_ROPE();
                float sbound;
                { const int ln = lane_now(); const float* kn = KIN(9) + l * 128; float gk = fmaxf(fabsf(kn[ln]), fabsf(kn[64 + ln])), gq = fmaxf(fabsf(qg[ln]), fabsf(qg[64 + ln]));
#pragma unroll
                  for (int of = 1; of < 64; of <<= 1) { gk = fmaxf(gk, __shfl_xor(gk, of)); gq = fmaxf(gq, __shfl_xor(gq, of)); }
                  sbound = 128.f * 1.03f * att::SCALE * att::LOG2E * __builtin_amdgcn_readfirstlane(gk) * __builtin_amdgcn_readfirstlane(gq); }
                const bool bounded = sbound <= 40.f;
                if (bounded) {
                for (int i = 0; i < 4; ++i) {
                    int h, qb, kvh, seq; size_t r0;
                    if (i < 2) { h = x; qb = c32 * 2 + i; kvh = h >> 2; seq = T0; r0 = 0; }
                    else { const int combo = x >> 1, s = 1 + (combo >> 1), ui = ((x & 1) * 32 + c32) * 2 + (i - 2); kvh = combo & 1; h = kvh * 4 + (ui >> 5); qb = ui & 31; seq = T1; r0 = (size_t)seq_start(s); }
                    att::attn_body<false, false>(QKV + (r0 + qb * 256) * NIN + h * 128, QKV + r0 * NIN + 1024 + kvh * 128, QKV + r0 * NIN + 1280 + kvh * 128,
                                          OB + (r0 + qb * 256) * DM + h * 128, seq, qb * 256, nullptr, 0.f, (att::lds_ptr)ldsl, (float*)(lds + AWS_OFF), qg, rope, sso + 16 * (r0 + qb * 256) + h, wave, sbound); }
                }
                if (!bounded) {
                for (int i = 0; i < 4; ++i) {
                    int h, qb, kvh, seq; size_t r0;
                    if (i < 2) { h = x; qb = c32 * 2 + i; kvh = h >> 2; seq = T0; r0 = 0; }
                    else { const int combo = x >> 1, s = 1 + (combo >> 1), ui = ((x & 1) * 32 + c32) * 2 + (i - 2); kvh = combo & 1; h = kvh * 4 + (ui >> 5); qb = ui & 31; seq = T1; r0 = (size_t)seq_start(s); }
                    att::attn_body<false, true>(QKV + (r0 + qb * 256) * NIN + h * 128, QKV + r0 * NIN + 1024 + kvh * 128, QKV + r0 * NIN + 1280 + kvh * 128,
                                          OB + (r0 + qb * 256) * DM + h * 128, seq, qb * 256, nullptr, 0.f, (att::lds_ptr)ldsl, (float*)(lds + AWS_OFF), qg, rope, sso + 16 * (r0 + qb * 256) + h, wave, 0.f); }
                }
                for (;;) {
                    __syncthreads();
                    if (wave == 0 && lane_now() == 0) MISC[13] = xb_add((unsigned*)((gu32*)(WSP() + WS_CTL) + CW_WQ + 64 * l), 1u);
                    __syncthreads();
                    const int t = lds_word_now<MISC_OFF + 52>();
                    if (t >= 1024) break;
                    const int h = 2 * (t & 3), rb = t >> 2, kvh = h >> 2, s = rb < 128 ? 0 : (rb < 192 ? 1 : 2); const size_t r0 = (size_t)seq_start(s);
                    const float* lut = (const float*)(lds + LUT_OFF) + h * LUT_STRIDE; const float sink2 = KIN(10)[l * 8 + h + (wave >> 2)] * LOG2E;
                    att::attn_body<true, true>(QKV + (size_t)(rb * 128) * NIN + 1536 + h * 128, QKV + r0 * NIN + 2560 + kvh * 128, QKV + r0 * NIN + 2816 + kvh * 128,
                                         OB + (size_t)(rb * 128) * DM + 1024 + h * 128, s == 0 ? T0 : T1, rb * 128 - (int)r0, lut, sink2, (att::lds_ptr)ldsl, (float*)(lds + AWS_OFF), nullptr, nullptr, sso + 16 * (size_t)(rb * 128) + 8 + h, wave, 0.f); }
            }
            GRID_BAR();
        }
        {   const int K = mlp ? DFF : DM; const bf16* Bt = (const bf16*)(WSP() + WS_W + (size_t)l * W_LAYER + (mlp ? W_DOWN : W_OUT));
            pg8::Gemm g{mlp ? P_H() : P_O(), Bt, M, DM, K}; pg8::StaticOrder S; S.init(M, DM, G, CU_SLOT(), 4, true);
            const bool nxt = hl + 1 < 2 * DEPTH;
            pg8::EpiRes E{P_XB(), P_MOD() + (size_t)l * 3 * MODW + (mlp ? 5 * DM : 2 * DM), mlp ? nullptr : P_SSOP(), nxt ? P_GV(hl + 1) : nullptr, P_XN(), P_SSP(), P_TAB(), (PG8_LAS float*)(ldsl + AWS_OFF), (PG8_LAS float*)(ldsl + VEC_OFF)};
            pg8::gemm_phase<pg8::EpiRes, pg8::StaticOrder, true, PG8_SP2>(ldsl + RING_OFF, g, S, E, wave);
        }
        SEAM_BAR(XL_ON() && hl + 1 < 2 * DEPTH);
    }
    {   LAUNDER_LANE(); float* outp = OUTP(); const float* gf = KIN(18); const bf16* XB = P_XB();
        for (int m0 = gw; m0 < M; m0 += 2 * NGW) {
            v4u w[2][4];
#pragma unroll
            for (int u = 0; u < 2; ++u)
#pragma unroll
                for (int j = 0; j < 4; ++j) w[u][j] = *(const v4u*)(XB + (size_t)(m0 + u * NGW) * DM + 8 * lane + 512 * j);
#pragma unroll
            for (int u = 0; u < 2; ++u) { const int m = m0 + u * NGW; float ss = 0.f;
#pragma unroll
                for (int j = 0; j < 4; ++j)
#pragma unroll
                    for (int e = 0; e < 4; ++e) { const float a = bf_lo(w[u][j][e]), b = bf_hi(w[u][j][e]); ss += a * a + b * b; }
                const float rinv = __builtin_amdgcn_rsqf(wave_sum(ss) * (1.f / DM) + EPS);
#pragma unroll
                for (int j = 0; j < 4; ++j) { const int c = 8 * lane + 512 * j; const f32x4 g0 = *(const f32x4*)(gf + c), g1 = *(const f32x4*)(gf + c + 4); f32x4 o0, o1;
                    o0.x = bf_lo(w[u][j].x) * rinv * g0.x; o0.y = bf_hi(w[u][j].x) * rinv * g0.y; o0.z = bf_lo(w[u][j].y) * rinv * g0.z; o0.w = bf_hi(w[u][j].y) * rinv * g0.w;
                    o1.x = bf_lo(w[u][j].z) * rinv * g1.x; o1.y = bf_hi(w[u][j].z) * rinv * g1.y; o1.z = bf_lo(w[u][j].w) * rinv * g1.z; o1.w = bf_hi(w[u][j].w) * rinv * g1.w;
                    *(f32x4*)(outp + (size_t)m * DM + c) = o0; *(f32x4*)(outp + (size_t)m * DM + c + 4) = o1; } }
        }
    }
#undef GRID_BAR
}

extern "C" void kernel_launch(void* const* d_in, const int* in_sizes, int n_in, void* d_out, int out_size, void* d_ws, size_t ws_size, hipStream_t stream) {
    static int grid = 0;
    if (grid == 0) {
        if (n_in != 19 || in_sizes[0] != T0 * DM || out_size != M * DM || ws_size < WS_END) { fprintf(stderr, "kernel_launch: shape mismatch (n_in %d, in0 %d, out %d, ws %zu need %zu)\n", n_in, n_in > 0 ? in_sizes[0] : -1, out_size, ws_size, (size_t)WS_END); grid = -1; return; }
        int dev = 0, cus = 0;
        if (hipGetDevice(&dev) != hipSuccess || hipDeviceGetAttribute(&cus, hipDeviceAttributeMultiprocessorCount, dev) != hipSuccess) { grid = -1; return; }
        if (hipFuncSetAttribute((const void*)fwd_kernel, hipFuncAttributeMaxDynamicSharedMemorySize, LDS_BYTES) != hipSuccess) { fprintf(stderr, "kernel_launch: hipFuncSetAttribute failed\n"); grid = -1; return; }
        (void)hipGetLastError();
        grid = cus;
        if (grid != 256) fprintf(stderr, "kernel_launch: %d CUs; the attention dealing assumes 256\n", grid);
    }
    if (grid < 0) return;
    if (hipMemsetAsync((char*)d_ws + WS_CTL, 0, CTL_ZERO_BYTES, stream) != hipSuccess) return;
    Args a{};
    for (int i = 0; i < 19; ++i) a.in[i] = (const float*)d_in[i];
    a.out = (float*)d_out; a.ws = (unsigned char*)d_ws;
    hipLaunchKernelGGL(fwd_kernel, dim3(grid), dim3(NWAVES * 64), LDS_BYTES, stream, a);
    const hipError_t le = hipPeekAtLastError();
    if (le != hipSuccess) fprintf(stderr, "kernel_launch: launch failed: %s\n", hipGetErrorName(le));
}
```

```cpp
#include <hip/hip_runtime.h>
#include <hip/hip_bf16.h>
#include <cstdio>
#include <cstdint>
namespace pg8 {
#define PG8_LAS __attribute__((address_space(3)))
typedef unsigned short bf16_t;
typedef short bf16x8 __attribute__((ext_vector_type(8)));
typedef float f32x4 __attribute__((ext_vector_type(4)));
typedef unsigned u32x4 __attribute__((ext_vector_type(4)));
constexpr int BM = 256, BK = 64, HALF = 128, HTB = HALF * BK * 2  , STAGE_BYTES = 8 * HTB, NXCD = 8, WGM = 8;

__host__ __device__ __forceinline__ int lds_byte(int r, int c) { const int st = (r >> 4) * 2 + (c >> 5), rr = r & 15, cc = c & 31, ob = rr * 64 + cc * 2; return st * 1024 + (ob ^ (((ob >> 9) & 1) << 5)); }
__host__ __device__ __forceinline__ void stage_rc(int b, int& R, int& C) { const int st = b / 1024, sb = b % 1024, swz = sb ^ (((sb >> 9) & 1) << 5); R = (st >> 1) * 16 + swz / 64; C = (st & 1) * 32 + (swz % 64) / 2; }
__host__ __device__ __forceinline__ int perm32(int rho) { const int n = rho >> 4, i = rho & 15; return 8 * (i >> 2) + 4 * n + (i & 3); }

struct Unit { int pm, pn; };
struct Gemm { const bf16_t* A; const bf16_t* Bt; int M, N, K; };

struct StaticOrder {
    int nM, nN, nwg, G, c, wgm; bool rev;
    __host__ __device__ void init(int M, int N, int G_, int c_, int wgm_ = WGM, bool rev_ = false) { nM = M / BM; nN = N / BM; nwg = nM * nN; G = G_; c = c_; wgm = wgm_; rev = rev_; }
    __host__ __device__ bool next(int i, Unit& u) const {
        const long L = (long)i * G + c; if (L >= nwg) return false;
        int wgid = (int)L; { const int q = nwg / NXCD, r = nwg % NXCD, xcd = wgid % NXCD, off = wgid / NXCD; wgid = (xcd < r ? xcd * (q + 1) : r * (q + 1) + (xcd - r) * q) + off; }
        const int nig = wgm * nN, gid = wgid / nig, fm = gid * wgm, gsz = (nM - fm) < wgm ? (nM - fm) : wgm;
        u.pm = fm + ((wgid % nig) % gsz); u.pn = (wgid % nig) / gsz; if (rev) u.pm ^= 15; return true;
    }
    __device__ __forceinline__ void a_ready(const Unit&) const {}
    __device__ __forceinline__ void done(const Unit&) const {}
};

__device__ __forceinline__ unsigned cvt_pk_bf16(float lo, float hi) { unsigned r; asm volatile("v_cvt_pk_bf16_f32 %0, %1, %2" : "=v"(r) : "v"(lo), "v"(hi)); return r; }
typedef float f32x2 __attribute__((ext_vector_type(2)));
__device__ __forceinline__ int seq_of_pm(int pm) { return pm < 64 ? 0 : (pm < 96 ? 1 : 2); }
__device__ __forceinline__ float relu1(float x) { float r; asm("v_max_f32_e32 %0, 0, %1" : "=v"(r) : "v"(x)); return r; }
struct EpiBf16 {
    static constexpr bool PERM = true, AFTER_DRAIN = false;
    bf16_t* O; int ldc; int act; const float* ssp; const float* bv; PG8_LAS f32x2* tab; PG8_LAS float* vec;
    __device__ __forceinline__ void midk(f32x4 (&)[2][2][4][2], const Unit&, int, int) const {}
    __device__ __forceinline__ bool has_midk() const { return false; }
    struct Pre { f32x4 a; float v; };
    __device__ __forceinline__ Pre prep_load(const Unit& u, int tid) const {
        const int row = tid >> 1, h = tid & 1; Pre r; r.a = *(const f32x4*)(ssp + (size_t)(u.pm * BM + row) * 8 + 4 * h);
        r.v = bv[(size_t)seq_of_pm(u.pm) * ldc + u.pn * BM + (tid & 255)]; return r;
    }
    __device__ __forceinline__ void prep_commit(const Pre& r, int tid) const {
        const int row = tid >> 1, h = tid & 1; const f32x4 a = r.a;
        float s = (a[0] + a[1]) + (a[2] + a[3]);
        const float o = __builtin_bit_cast(float, __builtin_amdgcn_mov_dpp(__builtin_bit_cast(int, s), 0xB1, 0xF, 0xF, true)); s = h ? o + s : s + o;
        if (h == 0) tab[row] = (f32x2){__builtin_amdgcn_rsqf(s * (1.f / 2048.f) + 1e-6f), 0.f};
        if (tid < 256) vec[tid] = r.v;
    }
    __device__ __forceinline__ void operator()(const f32x4 (&acc)[2][2][4][2], const Unit& u, int wr, int wc, int fr, int fq) const {
        const int row0 = u.pm * BM + wr * 64 + fr; const int col0 = u.pn * BM + wc * 32 + 8 * fq;
        f32x4 b[2][2];
#pragma unroll
        for (int bj = 0; bj < 2; ++bj)
#pragma unroll
            for (int n = 0; n < 2; ++n) b[bj][n] = *(const PG8_LAS f32x4*)(vec + wc * 32 + 8 * fq + bj * HALF + 4 * n);
#pragma unroll
        for (int ai = 0; ai < 2; ++ai)
#pragma unroll
            for (int m = 0; m < 4; ++m) { bf16_t* rowp = O + (size_t)(row0 + ai * HALF + m * 16) * ldc + col0;
                const float r = tab[ai * HALF + wr * 64 + m * 16 + fr].x;
#pragma unroll
                for (int bj = 0; bj < 2; ++bj) { f32x4 v0 = acc[ai][bj][m][0] * r + b[bj][0], v1 = acc[ai][bj][m][1] * r + b[bj][1];
                    if (act) {
#pragma unroll
                        for (int j = 0; j < 4; ++j) { const float a = relu1(v0[j]), c = relu1(v1[j]); v0[j] = a * a; v1[j] = c * c; } }
                    u32x4 w; w.x = cvt_pk_bf16(v0[0], v0[1]); w.y = cvt_pk_bf16(v0[2], v0[3]); w.z = cvt_pk_bf16(v1[0], v1[1]); w.w = cvt_pk_bf16(v1[2], v1[3]);
                    *(u32x4*)(rowp + bj * HALF) = w; } }
    }
};
struct EpiRes {
    static constexpr bool PERM = true, AFTER_DRAIN = false;
    bf16_t* xb; const float* gate; const float* ssop; const float* gn; bf16_t* xn; float* sspn; PG8_LAS f32x2* tab; PG8_LAS float* stg; PG8_LAS float* vec;
    __device__ __forceinline__ bool has_midk() const { return ssop != nullptr; }
    struct Pre { f32x4 a, b; float v; };
    __device__ __forceinline__ Pre prep_load(const Unit& u, int tid) const {
        Pre r; r.a = (f32x4){0.f, 0.f, 0.f, 0.f}; r.b = r.a; const int s = seq_of_pm(u.pm), c = u.pn * BM + (tid & 255);
        r.v = tid < 256 ? gate[s * 12288 + c] : (gn ? gn[s * 2048 + c] : 0.f);
        if (!ssop) return r;
        const int row = tid >> 1, h = tid & 1; const f32x4* p = (const f32x4*)(ssop + (size_t)(u.pm * BM + row) * 16 + 8 * h);
        r.a = p[0]; r.b = p[1]; return r;
    }
    __device__ __forceinline__ void prep_commit(const Pre& r, int tid) const {
        vec[tid] = r.v;
        if (!ssop) return;
        const int row = tid >> 1, h = tid & 1; const f32x4 a = r.a, b = r.b;
        const float s = ((a[0] + a[1]) + (a[2] + a[3])) + ((b[0] + b[1]) + (b[2] + b[3])); const float o = __builtin_bit_cast(float, __builtin_amdgcn_mov_dpp(__builtin_bit_cast(int, s), 0xB1, 0xF, 0xF, true));
        const float sA = h ? o : s, sB = h ? s : o;
        const float qB = sB * (1.f / 1024.f) + 1e-6f;
        if (h == 0) tab[row] = (f32x2){__builtin_amdgcn_rsqf(sA * (1.f / 1024.f) + 1e-6f) * __builtin_amdgcn_sqrtf(qB), __builtin_amdgcn_rsqf(qB)};
    }
    __device__ __forceinline__ void midk(f32x4 (&acc)[2][2][4][2], const Unit& u, int wr, int fr) const {
#pragma unroll
        for (int ai = 0; ai < 2; ++ai)
#pragma unroll
            for (int m = 0; m < 4; ++m) { const float f = tab[ai * HALF + wr * 64 + m * 16 + fr].x;
#pragma unroll
                for (int bj = 0; bj < 2; ++bj)
#pragma unroll
                    for (int n = 0; n < 2; ++n) acc[ai][bj][m][n] *= f; }
    }
    __device__ __forceinline__ void operator()(const f32x4 (&acc)[2][2][4][2], const Unit& u, int wr, int wc, int fr, int fq) const {
        const int row0 = u.pm * BM + wr * 64 + fr, col0 = u.pn * BM + wc * 32 + 8 * fq;
        const PG8_LAS float* gl = vec + wc * 32 + 8 * fq; const PG8_LAS float* xl = gl + 256;
        u32x4 bw0[4][2], bw1[4][2];
#pragma unroll
        for (int m = 0; m < 4; ++m)
#pragma unroll
            for (int bj = 0; bj < 2; ++bj) bw0[m][bj] = *(const u32x4*)(xb + (size_t)(row0 + m * 16) * 2048 + col0 + bj * HALF);
        asm volatile("" ::: "memory");
#define EPIRES_GROUP(ai, m, BW) do { const size_t ro = (size_t)(row0 + (ai) * HALF + (m) * 16) * 2048 + col0; \
            const float pr = ssop ? tab[(ai) * HALF + wr * 64 + (m) * 16 + fr].y : 1.f; float sq = 0.f; \
            _Pragma("unroll") for (int bj = 0; bj < 2; ++bj) { const u32x4 b = BW[m][bj]; \
                const f32x4 g0 = *(const PG8_LAS f32x4*)(gl + bj * HALF), g1 = *(const PG8_LAS f32x4*)(gl + bj * HALF + 4); \
                f32x4 b0, b1; \
                b0[0] = __uint_as_float(b.x << 16); b0[1] = __uint_as_float(b.x & 0xffff0000u); b0[2] = __uint_as_float(b.y << 16); b0[3] = __uint_as_float(b.y & 0xffff0000u); \
                b1[0] = __uint_as_float(b.z << 16); b1[1] = __uint_as_float(b.z & 0xffff0000u); b1[2] = __uint_as_float(b.w << 16); b1[3] = __uint_as_float(b.w & 0xffff0000u); \
                const f32x4 x0 = b0 + g0 * (acc[ai][bj][m][0] * pr), x1 = b1 + g1 * (acc[ai][bj][m][1] * pr); \
                u32x4 w; w.x = cvt_pk_bf16(x0[0], x0[1]); w.y = cvt_pk_bf16(x0[2], x0[3]); w.z = cvt_pk_bf16(x1[0], x1[1]); w.w = cvt_pk_bf16(x1[2], x1[3]); \
                *(u32x4*)(xb + ro + bj * HALF) = w; \
                if (gn) { sq += ((x0[0] * x0[0] + x0[1] * x0[1]) + (x0[2] * x0[2] + x0[3] * x0[3])) + ((x1[0] * x1[0] + x1[1] * x1[1]) + (x1[2] * x1[2] + x1[3] * x1[3])); \
                    const f32x4 y0 = x0 * *(const PG8_LAS f32x4*)(xl + bj * HALF), y1 = x1 * *(const PG8_LAS f32x4*)(xl + bj * HALF + 4); \
                    u32x4 v; v.x = cvt_pk_bf16(y0[0], y0[1]); v.y = cvt_pk_bf16(y0[2], y0[3]); v.z = cvt_pk_bf16(y1[0], y1[1]); v.w = cvt_pk_bf16(y1[2], y1[3]); \
                    *(u32x4*)(xn + ro + bj * HALF) = v; } } \
            if (gn) { { auto r1_ = __builtin_amdgcn_permlane16_swap(__float_as_uint(sq), __float_as_uint(sq), false, false); sq = __uint_as_float(r1_[0]) + __uint_as_float(r1_[1]); }     \
                { auto r2_ = __builtin_amdgcn_permlane32_swap(__float_as_uint(sq), __float_as_uint(sq), false, false); sq = __uint_as_float(r2_[0]) + __uint_as_float(r2_[1]); }                        \
                if (fq == 0) stg[((ai) * HALF + wr * 64 + (m) * 16 + fr) * 4 + wc] = sq; } } while (0)
#pragma unroll
        for (int m = 0; m < 4; ++m) { EPIRES_GROUP(0, m, bw0);
            asm volatile("" ::: "memory");
#pragma unroll
            for (int bj = 0; bj < 2; ++bj) bw1[m][bj] = *(const u32x4*)(xb + (size_t)(row0 + HALF + m * 16) * 2048 + col0 + bj * HALF);
            asm volatile("" ::: "memory"); }
#pragma unroll
        for (int m = 0; m < 4; ++m) EPIRES_GROUP(1, m, bw1);
        asm volatile("" ::: "memory");
#undef EPIRES_GROUP
        if (gn) {
            asm volatile("s_waitcnt lgkmcnt(0)" ::: "memory"); __builtin_amdgcn_s_barrier(); asm volatile("" ::: "memory");
            const int t = (wr * 4 + wc) * 64 + fq * 16 + fr;
            if (t < 256) { const f32x4 v = *(const PG8_LAS f32x4*)(stg + t * 4); sspn[(size_t)(u.pm * BM + t) * 8 + u.pn] = (v[0] + v[1]) + (v[2] + v[3]); }
        }
    }
};
template <class Epi, class Sched, bool ALIGN_EPI = false, bool SP2 = false>
__device__ __forceinline__ void gemm_phase(PG8_LAS unsigned char* lds, const Gemm g, const Sched& S, const Epi& E, int wv  ) {
    int lane_; asm volatile("v_mbcnt_lo_u32_b32 %0, -1, 0\n\tv_mbcnt_hi_u32_b32 %0, -1, %0" : "=v"(lane_));
    asm volatile("" : "+s"(wv));
    const int tid = wv * 64 + lane_, wid = wv, lane = tid & 63, wr = wid >> 2, wc = wid & 3, fr = lane & 15, fq = lane >> 4;
    const int K = g.K, nt = K / BK;
    unsigned voffA[2], voffB[2];
#pragma unroll
    for (int i = 0; i < 2; ++i) { int R, C; stage_rc(tid * 16 + i * 8192, R, C); const int Rb = Epi::PERM ? ((R & ~31) + perm32(R & 31)) : R;
        voffA[i] = (unsigned)(R * K + C) * 2u; voffB[i] = (unsigned)(Rb * K + C) * 2u; }
    const size_t kstep = (size_t)(BK * 2);
    const size_t hstep = (size_t)HALF * K * 2;
    const size_t tstep = 2 * hstep;
    const unsigned ldsw = (unsigned)wid * 1024u;
    const int aoff = lds_byte(wr * 64 + fr, fq * 8), boff = lds_byte(wc * 32 + fr, fq * 8);
#define PG8_SA(b, h) (((b) * 2 + (h)) * HTB)
#define PG8_SB(b, h) ((4 + (b) * 2 + (h)) * HTB)
#define PG8_STAGE(bufoff, gbase, voff) do { _Pragma("unroll") for (int _i = 0; _i < 2; ++_i) \
        __builtin_amdgcn_global_load_lds((const unsigned*)((const char*)(gbase) + (voff)[_i]), (PG8_LAS unsigned*)(lds + (bufoff) + ldsw + _i * 8192), 16, 0, 0); } while (0)
#define PG8_LDA(dst, b, h) do { _Pragma("unroll") for (int m = 0; m < 4; ++m) _Pragma("unroll") for (int k = 0; k < 2; ++k) dst[m][k] = *(const PG8_LAS bf16x8*)(lds + PG8_SA(b, h) + aoff + m * 2048 + k * 1024); } while (0)
#define PG8_LDB(dst, b, h) do { _Pragma("unroll") for (int n = 0; n < 2; ++n) _Pragma("unroll") for (int k = 0; k < 2; ++k) dst[n][k] = *(const PG8_LAS bf16x8*)(lds + PG8_SB(b, h) + boff + n * 2048 + k * 1024); } while (0)
#define PG8_MMA(ai, bj, At, Bt) do { __builtin_amdgcn_s_setprio(1); _Pragma("unroll") for (int m = 0; m < 4; ++m) _Pragma("unroll") for (int n = 0; n < 2; ++n) _Pragma("unroll") for (int k = 0; k < 2; ++k) \
        acc[ai][bj][m][n] = __builtin_amdgcn_mfma_f32_16x16x32_bf16(Bt[n][k], At[m][k], acc[ai][bj][m][n], 0, 0, 0); __builtin_amdgcn_s_setprio(0); } while (0)
#define PG8_WAIT_V(n) asm volatile("s_waitcnt vmcnt(" #n ")" ::: "memory")
#define PG8_WAIT_V8_NZ(t) asm volatile("s_cmp_eq_u32 %0, 0\n\ts_cbranch_scc1 1f\n\ts_waitcnt vmcnt(8)\n1:" :: "s"(t) : "scc", "memory")
#define PG8_WAIT_L(n) asm volatile("s_waitcnt lgkmcnt(" #n ")" ::: "memory")
#define PG8_BAR __builtin_amdgcn_s_barrier()
#define PG8_SCHED __builtin_amdgcn_sched_barrier(0)
    Unit cur, nxt; int ui = 0;
    if (!S.next(0, cur)) return;
    { const typename Epi::Pre pr0 = E.prep_load(cur, tid); E.prep_commit(pr0, tid); } asm volatile("s_waitcnt lgkmcnt(0)" ::: "memory"); PG8_BAR; asm volatile("" ::: "memory");
    f32x4 acc[2][2][4][2];
#pragma unroll
    for (int a = 0; a < 2; ++a)
#pragma unroll
        for (int b = 0; b < 2; ++b)
#pragma unroll
            for (int m = 0; m < 4; ++m)
#pragma unroll
                for (int n = 0; n < 2; ++n) acc[a][b][m][n] = (f32x4){0.f, 0.f, 0.f, 0.f};
    bf16x8 At[4][2], B0[2][2], B1[2][2];
    const char* cA = (const char*)g.A + (size_t)cur.pm * tstep; const char* cB = (const char*)g.Bt + (size_t)cur.pn * tstep;
    S.a_ready(cur);
    if constexpr (SP2) {
        PG8_STAGE(PG8_SB(0, 0), cB, voffB); PG8_STAGE(PG8_SB(0, 1), cB + hstep, voffB); PG8_STAGE(PG8_SA(0, 0), cA, voffA); PG8_STAGE(PG8_SA(0, 1), cA + hstep, voffA);
        PG8_STAGE(PG8_SB(1, 0), cB + kstep, voffB); PG8_STAGE(PG8_SA(1, 0), cA + kstep, voffA); PG8_STAGE(PG8_SB(1, 1), cB + hstep + kstep, voffB); PG8_STAGE(PG8_SA(1, 1), cA + hstep + kstep, voffA);
        if (wr == 1) PG8_BAR;
        PG8_WAIT_V(0); PG8_BAR;
        PG8_BAR;
    } else {
        PG8_STAGE(PG8_SB(0, 0), cB, voffB); PG8_STAGE(PG8_SA(0, 0), cA, voffA); PG8_STAGE(PG8_SB(0, 1), cB + hstep, voffB); PG8_STAGE(PG8_SA(0, 1), cA + hstep, voffA);
        if (wr == 1) PG8_BAR;
        PG8_WAIT_V(4); PG8_BAR;
        PG8_STAGE(PG8_SB(1, 0), cB + kstep, voffB); PG8_STAGE(PG8_SA(1, 0), cA + kstep, voffA); PG8_STAGE(PG8_SB(1, 1), cB + hstep + kstep, voffB);
        PG8_WAIT_V(6); PG8_BAR;
    }
    for (;;) {
        const bool has_next = S.next(ui + 1, nxt);
        const char* nA = has_next ? (const char*)g.A + (size_t)nxt.pm * tstep : cA; const char* nB = has_next ? (const char*)g.Bt + (size_t)nxt.pn * tstep : cB;
        for (int t = 0; t < nt; t += 2) {
            const bool last = (t == nt - 2);
            if (E.has_midk() && t == (nt >> 1)) E.midk(acc, cur, wr, fr);
            const char* a1 = cA + (size_t)(t + 1) * kstep;
            const char* a2 = last ? nA : cA + (size_t)(t + 2) * kstep; const char* b2 = last ? nB : cB + (size_t)(t + 2) * kstep;
            const char* a3 = a2 + kstep; const char* b3 = b2 + kstep;
            if (last && has_next) S.a_ready(nxt);
            if constexpr (SP2) {
            PG8_LDB(B0, 0, 0); PG8_LDB(B1, 0, 1); PG8_SCHED; PG8_LDA(At, 0, 0); PG8_STAGE(PG8_SA(1, 1), a1 + hstep, voffA);
            PG8_WAIT_V8_NZ(t); PG8_WAIT_L(0); PG8_BAR; PG8_MMA(0, 0, At, B0); PG8_MMA(0, 1, At, B1); PG8_BAR; PG8_SCHED;
            PG8_LDA(At, 0, 1); PG8_STAGE(PG8_SB(0, 0), b2, voffB); PG8_STAGE(PG8_SB(0, 1), b2 + hstep, voffB); PG8_STAGE(PG8_SA(0, 0), a2, voffA);
            PG8_WAIT_V8_NZ(t); PG8_WAIT_L(0); PG8_BAR; PG8_MMA(1, 0, At, B0); PG8_MMA(1, 1, At, B1); PG8_BAR; PG8_SCHED;
            PG8_LDB(B0, 1, 0); PG8_LDB(B1, 1, 1); PG8_SCHED; PG8_LDA(At, 1, 0); PG8_STAGE(PG8_SA(0, 1), a2 + hstep, voffA);
            PG8_WAIT_V8_NZ(t); PG8_WAIT_L(0); PG8_BAR; PG8_MMA(0, 0, At, B0); PG8_MMA(0, 1, At, B1); PG8_BAR; PG8_SCHED;
            PG8_LDA(At, 1, 1); PG8_STAGE(PG8_SB(1, 0), b3, voffB); PG8_STAGE(PG8_SB(1, 1), b3 + hstep, voffB); PG8_STAGE(PG8_SA(1, 0), a3, voffA);
            PG8_WAIT_V(8); PG8_WAIT_L(0); PG8_BAR; PG8_MMA(1, 0, At, B0); PG8_MMA(1, 1, At, B1); PG8_BAR; PG8_SCHED;
            } else {
            PG8_LDB(B0, 0, 0); PG8_SCHED; PG8_LDA(At, 0, 0); PG8_STAGE(PG8_SA(1, 1), a1 + hstep, voffA);
            PG8_WAIT_L(8); PG8_BAR; PG8_WAIT_L(0); PG8_MMA(0, 0, At, B0); PG8_BAR; PG8_SCHED;
            PG8_LDB(B1, 0, 1); PG8_STAGE(PG8_SB(0, 0), b2, voffB);
            PG8_BAR; PG8_WAIT_L(0); PG8_MMA(0, 1, At, B1); PG8_BAR;
            PG8_LDA(At, 0, 1); PG8_STAGE(PG8_SA(0, 0), a2, voffA);
            PG8_BAR; PG8_WAIT_L(0); PG8_MMA(1, 0, At, B0); PG8_BAR; PG8_SCHED;
            PG8_STAGE(PG8_SB(0, 1), b2 + hstep, voffB);
            PG8_WAIT_V(6); PG8_BAR; PG8_MMA(1, 1, At, B1); PG8_BAR;
            PG8_LDB(B0, 1, 0); PG8_SCHED; PG8_LDA(At, 1, 0); PG8_STAGE(PG8_SA(0, 1), a2 + hstep, voffA);
            PG8_WAIT_L(8); PG8_BAR; PG8_WAIT_L(0); PG8_MMA(0, 0, At, B0); PG8_BAR; PG8_SCHED;
            PG8_LDB(B1, 1, 1); PG8_STAGE(PG8_SB(1, 0), b3, voffB);
            PG8_BAR; PG8_WAIT_L(0); PG8_MMA(0, 1, At, B1); PG8_BAR;
            PG8_LDA(At, 1, 1); PG8_STAGE(PG8_SA(1, 0), a3, voffA);
            PG8_BAR; PG8_WAIT_L(0); PG8_MMA(1, 0, At, B0); PG8_BAR; PG8_SCHED;
            PG8_STAGE(PG8_SB(1, 1), b3 + hstep, voffB);
            PG8_WAIT_V(6); PG8_BAR; PG8_MMA(1, 1, At, B1); PG8_BAR;
            }
        }
        if constexpr (ALIGN_EPI) { if (wr == 0) PG8_BAR; }
        if constexpr (SP2) { if (has_next) PG8_STAGE(PG8_SA(1, 1), nA + kstep + hstep, voffA); } asm volatile("" ::: "memory");
        if constexpr (!Epi::AFTER_DRAIN) {
            typename Epi::Pre prn; if (has_next) { int ln_; asm volatile("v_mbcnt_lo_u32_b32 %0, -1, 0\n\tv_mbcnt_hi_u32_b32 %0, -1, %0" : "=v"(ln_)); prn = E.prep_load(nxt, wid * 64 + ln_); }
            asm volatile("" ::: "memory");
            E(acc, cur, wr, wc, fr, fq); S.done(cur);
            if constexpr (ALIGN_EPI) { if (has_next) { asm volatile("s_waitcnt lgkmcnt(0)" ::: "memory"); PG8_BAR; asm volatile("" ::: "memory"); { int ln_; asm volatile("v_mbcnt_lo_u32_b32 %0, -1, 0\n\tv_mbcnt_hi_u32_b32 %0, -1, %0" : "=v"(ln_)); E.prep_commit(prn, wid * 64 + ln_); } asm volatile("s_waitcnt lgkmcnt(0)" ::: "memory"); } } }
        if (!has_next) break;
#pragma unroll
        for (int a = 0; a < 2; ++a)
#pragma unroll
            for (int b = 0; b < 2; ++b)
#pragma unroll
                for (int m = 0; m < 4; ++m)
#pragma unroll
                    for (int n = 0; n < 2; ++n) acc[a][b][m][n] = (f32x4){0.f, 0.f, 0.f, 0.f};
        cur = nxt; cA = nA; cB = nB; ++ui;
        if constexpr (ALIGN_EPI) { if (wr == 1) PG8_BAR; }
    }
    PG8_WAIT_V(0);
    if constexpr (!ALIGN_EPI) { if (wr == 0) PG8_BAR; }
    PG8_BAR;
    if constexpr (Epi::AFTER_DRAIN) { E.fused(acc, cur, wr, wc, fr, fq, lds, wid, lane); S.done(cur); }
#undef PG8_SA
#undef PG8_SB
#undef PG8_STAGE
#undef PG8_LDA
#undef PG8_LDB
#undef PG8_MMA
#undef PG8_WAIT_V
#undef PG8_WAIT_V8_NZ
#undef PG8_WAIT_L
#undef PG8_BAR
#undef PG8_SCHED
}
}
namespace att {
#define ATT_DEFER_L 1
using bf16 = __hip_bfloat16;
constexpr int   D = 128, NW = 8, QBLK = 32, KVBLK = 64;
constexpr float SCALE = 0.088388347648318440f;
constexpr float LOG2E = 1.4426950408889634f;
constexpr int LDQ = 3072, LDK = 3072, LDO = 2048;
constexpr size_t SHM_V = KVBLK * D * 2, SHM_K = KVBLK * D * 2, SHM_ATTN = 2 * SHM_V + 2 * SHM_K + NW * 64 * 4;

using bf16x8 = __attribute__((ext_vector_type(8))) short;
using s16x4  = __attribute__((ext_vector_type(4))) short;
using f32x16 = __attribute__((ext_vector_type(16))) float;
using u32x4  = __attribute__((ext_vector_type(4))) unsigned;
using f32x4v = __attribute__((ext_vector_type(4))) float;
typedef __attribute__((address_space(3))) char* lds_ptr;
typedef __attribute__((address_space(3))) const char* lds_cptr;
#define KSWZ(row, colB) ((row) * 256 + ((colB) ^ (((row) & 7) << 4)))
#define SBAR() __builtin_amdgcn_sched_barrier(0)
__device__ __forceinline__ int crow(int r, int hi) { return (r & 3) + 8 * (r >> 2) + 4 * hi; }
__device__ __forceinline__ unsigned cvtpk(float lo, float hi) { unsigned r; asm volatile("v_cvt_pk_bf16_f32 %0, %1, %2" : "=v"(r) : "v"(lo), "v"(hi)); return r; }
__device__ __forceinline__ bf16x8 ld8(const bf16* p) { return *reinterpret_cast<const bf16x8*>(p); }

__device__ __forceinline__ float fadd_s(float a, float b) { float r; asm("v_add_f32_e32 %0, %1, %2" : "=v"(r) : "v"(a), "v"(b)); return r; }
typedef short v4i16_t __attribute__((ext_vector_type(4)));
__device__ __forceinline__ s16x4 vtr(const __attribute__((address_space(3))) char* p) { return __builtin_bit_cast(s16x4, __builtin_amdgcn_ds_read_tr16_b64_v4i16((__attribute__((address_space(3))) v4i16_t*)p)); }
__device__ __forceinline__ float rowmax32(const f32x16& p0, const f32x16& p1) {
  float a = fmaxf(fmaxf(p0[0], p0[1]), p1[0]), b = fmaxf(fmaxf(p0[2], p0[3]), p1[1]); a = fmaxf(fmaxf(a, p1[2]), p1[3]);
#pragma unroll
  for (int r = 4; r < 16; r += 4) { a = fmaxf(fmaxf(a, p0[r]), p0[r + 1]); b = fmaxf(fmaxf(b, p0[r + 2]), p0[r + 3]); a = fmaxf(fmaxf(a, p1[r]), p1[r + 1]); b = fmaxf(fmaxf(b, p1[r + 2]), p1[r + 3]); }
  float m = fmaxf(a, b);
  auto rr = __builtin_amdgcn_permlane32_swap(__float_as_uint(m), __float_as_uint(m), false, false);
  return fmaxf(__uint_as_float(rr[0]), __uint_as_float(rr[1]));
}
__device__ __forceinline__ void psm_start(f32x16& p0, f32x16& p1, f32x16& negm, float& mref) {
  const float pm = rowmax32(p0, p1); const float d = pm > -1e30f ? pm : 0.f;
  mref = d;
#pragma unroll
  for (int r = 0; r < 16; ++r) { p0[r] -= d; p1[r] -= d; negm[r] = -d; }
  asm volatile("" : "+v"(negm));
#pragma unroll
  for (int r = 0; r < 16; ++r) p0[r] = __builtin_amdgcn_exp2f(p0[r]);
}
__device__ __forceinline__ void psm_next(f32x16& p0, f32x16& p1, f32x16& negm, float& mref, float& alpha) {
  constexpr float THR2 = 11.0f;
  const float pm = rowmax32(p0, p1);
  if (__builtin_expect(__all(pm <= THR2), 1)) { alpha = 1.f; }
  else { const float d = fmaxf(pm, 0.f); mref += d; alpha = __builtin_amdgcn_exp2f(-d);
#pragma unroll
    for (int r = 0; r < 16; ++r) { p0[r] -= d; p1[r] -= d; negm[r] = -mref; }
    asm volatile("" : "+v"(negm)); }
#pragma unroll
  for (int r = 0; r < 16; ++r) p0[r] = __builtin_amdgcn_exp2f(p0[r]);
}
constexpr int WLUT_OFF = 146048, WCOPY = 456, WTAB_BYTES = 4 * WCOPY * 4, WLUT_STRIDE = 260, WROWS = 128;
__device__ __forceinline__ void win_bias_tab(f32x16& p0, f32x16& p1, int dq, lds_cptr tab, int hi) {
  const int e0 = dq + 4 * hi + 224, s = e0 & 3;
  const lds_cptr a = tab + s * (WCOPY * 4) + (e0 - s) * 4;
#pragma unroll
  for (int g = 0; g < 4; ++g) { const f32x4v b0 = *(const __attribute__((address_space(3))) f32x4v*)(a + 32 * g), b1 = *(const __attribute__((address_space(3))) f32x4v*)(a + 128 + 32 * g);
#pragma unroll
    for (int j = 0; j < 4; ++j) { p0[4 * g + j] += b0[j]; p1[4 * g + j] += b1[j]; } }
}
template <bool NOPERM  >
__device__ __forceinline__ void finishSM(f32x16& p0, f32x16& p1, float alpha, float& l_reg, bf16x8& pa0, bf16x8& pa1, bf16x8& pa2, bf16x8& pa3) {
  for (int r = 0; r < 16; ++r) p1[r] = __builtin_amdgcn_exp2f(p1[r]);
  typedef float f2_t __attribute__((ext_vector_type(2)));
  f2_t s2 = (f2_t){p0[0], p0[1]} + (f2_t){p1[0], p1[1]};
#pragma unroll
  for (int r = 2; r < 16; r += 2) { s2 += (f2_t){p0[r], p0[r + 1]}; s2 += (f2_t){p1[r], p1[r + 1]}; }
  float ps = s2.x + s2.y;
  if constexpr (!NOPERM || !ATT_DEFER_L) { auto rr = __builtin_amdgcn_permlane32_swap(__float_as_uint(ps), __float_as_uint(ps), false, false); ps = __uint_as_float(rr[0]) + __uint_as_float(rr[1]); }
  l_reg = l_reg * alpha + ps;
#define PK4(P, BASE, OUT) do { if constexpr (NOPERM) { u32x4 w = {cvtpk(P[BASE + 0], P[BASE + 1]), cvtpk(P[BASE + 2], P[BASE + 3]), cvtpk(P[BASE + 4], P[BASE + 5]), cvtpk(P[BASE + 6], P[BASE + 7])}; OUT = *reinterpret_cast<bf16x8*>(&w); } \
    else { unsigned a0 = cvtpk(P[BASE + 0], P[BASE + 1]), a1 = cvtpk(P[BASE + 2], P[BASE + 3]); unsigned b0 = cvtpk(P[BASE + 4], P[BASE + 5]), b1 = cvtpk(P[BASE + 6], P[BASE + 7]); \
      auto r0 = __builtin_amdgcn_permlane32_swap(a0, b0, false, false); auto r1 = __builtin_amdgcn_permlane32_swap(a1, b1, false, false); \
      u32x4 w = {r0[0], r1[0], r0[1], r1[1]}; OUT = *reinterpret_cast<bf16x8*>(&w); } } while (0)
  PK4(p0, 0, pa0); asm volatile("" : "+v"(pa0)); PK4(p0, 8, pa1); asm volatile("" : "+v"(pa1)); PK4(p1, 0, pa2); asm volatile("" : "+v"(pa2)); PK4(p1, 8, pa3); asm volatile("" : "+v"(pa3));
#undef PK4
}
__device__ __forceinline__ void qkt(f32x16& p0, f32x16& p1, const bf16* Ks, const bf16x8* qr, int r32, int hi) {
  p0 = f32x16{}; p1 = f32x16{};
  for (int d0 = 0; d0 < 8; ++d0) { int cb = (d0 * 16 + hi * 8) * 2;
    bf16x8 b0 = *reinterpret_cast<const bf16x8*>((const char*)Ks + KSWZ(r32, cb));
    bf16x8 b1 = *reinterpret_cast<const bf16x8*>((const char*)Ks + KSWZ(32 + r32, cb));
    p0 = __builtin_amdgcn_mfma_f32_32x32x16_bf16(b0, qr[d0], p0, 0, 0, 0);
    p1 = __builtin_amdgcn_mfma_f32_32x32x16_bf16(b1, qr[d0], p1, 0, 0, 0); }
}
__device__ __forceinline__ int v_st(int k, int c) { const int kk = (k & ~0xC) | ((k & 4) << 1) | ((k & 8) >> 1); return ((kk >> 3) * 4 + (c >> 5)) * 512 + ((kk & 7) * 32 + (c & 31)) * 2; }
__device__ __forceinline__ int v_rd_base(int lane) { return ((lane & 3) << 3) | (((lane >> 2) & 3) << 6) | (((lane >> 4) & 1) << 5) | (((lane >> 5) & 1) << 8); }
constexpr int v_rd_off(int d0, int ks, int half) { return d0 * 512 + ks * 4096 + half * 2048; }
template <int OFF> __device__ __forceinline__ void k_rda(bf16x8& f, int addr) { asm volatile("ds_read_b128 %0, %1 offset:%2" : "=v"(f) : "v"(addr), "n"(OFF)); }
template <int N> __device__ __forceinline__ void k_wt(bf16x8& f) { asm volatile("s_waitcnt lgkmcnt(%1)" : "+v"(f) : "n"(N)); }
template <int N> __device__ __forceinline__ void v_wt(s16x4& l, s16x4& h) { asm volatile("s_waitcnt lgkmcnt(%2)" : "+v"(l), "+v"(h) : "n"(N)); }
template <int OFF> __device__ __forceinline__ s16x4 tr_read(int vb) {
  s16x4 r; asm volatile("ds_read_b64_tr_b16 %0, %1 offset:%2" : "=&v"(r) : "v"(vb), "i"(OFF) : "memory"); return r;
}
template <int KS> __device__ __forceinline__ void pv_ks(f32x16* o, int vb, bf16x8 pa) {
  const s16x4 l0 = tr_read<v_rd_off(0, KS, 0)>(vb), h0 = tr_read<v_rd_off(0, KS, 1)>(vb), l1 = tr_read<v_rd_off(1, KS, 0)>(vb), h1 = tr_read<v_rd_off(1, KS, 1)>(vb);
  const s16x4 l2 = tr_read<v_rd_off(2, KS, 0)>(vb), h2 = tr_read<v_rd_off(2, KS, 1)>(vb), l3 = tr_read<v_rd_off(3, KS, 0)>(vb), h3 = tr_read<v_rd_off(3, KS, 1)>(vb);
  asm volatile("s_waitcnt lgkmcnt(0)" ::: "memory"); SBAR();
#define PK(L, H) (bf16x8){L[0], L[1], L[2], L[3], H[0], H[1], H[2], H[3]}
  o[0] = __builtin_amdgcn_mfma_f32_32x32x16_bf16(pa, PK(l0, h0), o[0], 0, 0, 0);
  o[1] = __builtin_amdgcn_mfma_f32_32x32x16_bf16(pa, PK(l1, h1), o[1], 0, 0, 0);
  o[2] = __builtin_amdgcn_mfma_f32_32x32x16_bf16(pa, PK(l2, h2), o[2], 0, 0, 0);
  o[3] = __builtin_amdgcn_mfma_f32_32x32x16_bf16(pa, PK(l3, h3), o[3], 0, 0, 0);
#undef PK
}
__device__ __forceinline__ void pv_d0(f32x16* o, int vb, bf16x8 pa0, bf16x8 pa1, bf16x8 pa2, bf16x8 pa3) {
  pv_ks<0>(o, vb, pa0); pv_ks<1>(o, vb, pa1); pv_ks<2>(o, vb, pa2); pv_ks<3>(o, vb, pa3);
}
constexpr int RING_SLOT = 16384, RING_V = 65536;
template <bool ZC  >
__device__ __forceinline__ void qkt_l(f32x16& p0, f32x16& p1, const lds_cptr* kb4, int koff, const bf16x8* qr, const f32x16& negm) {
#pragma unroll
  for (int d0 = 0; d0 < 8; ++d0) { const lds_cptr a = kb4[d0 & 3] + koff + (d0 >> 2) * 128;
    const bf16x8 b0 = *(const __attribute__((address_space(3))) bf16x8*)(a);
    const bf16x8 b1 = *(const __attribute__((address_space(3))) bf16x8*)(a + 32 * 256);
    p0 = __builtin_amdgcn_mfma_f32_32x32x16_bf16(b0, qr[d0], d0 == 0 ? (ZC ? f32x16{} : negm) : p0, 0, 0, 0);
    p1 = __builtin_amdgcn_mfma_f32_32x32x16_bf16(b1, qr[d0], d0 == 0 ? (ZC ? f32x16{} : negm) : p1, 0, 0, 0); }
}
template <bool WIN, bool DYN>
__device__ __forceinline__ void attn_body(const bf16* __restrict__ Qb, const bf16* __restrict__ Kh, const bf16* __restrict__ Vh,
                                          bf16* __restrict__ Ob, int seq, int P0, const float* lut, float sink2, lds_ptr ring, float* wsbase,
                                          const float* __restrict__ qg, const float* __restrict__ rope, float* sso, int wv, float sbound) {
  static_assert(DYN || !WIN, "the fixed-reference softmax needs bounded scores (normalised q and k)");
  int lane_; asm volatile("v_mbcnt_lo_u32_b32 %0, -1, 0\n\tv_mbcnt_hi_u32_b32 %0, -1, %0" : "=v"(lane_));
  asm volatile("" : "+s"(wv));
  const int wid = wv, lane = lane_, r32 = lane & 31, hi = lane >> 5;
  float* ws = wsbase + wid * 64; float* li_l = ws; float* al_l = ws + 32;
  float mref = 0.f, l_reg = 0; f32x16 o[4] = {}; bf16x8 qr[8]; f32x16 negm = f32x16{}; constexpr bool dyn = DYN;
  (void)sbound;
  asm volatile("" : "+v"(negm));
  const int wrow = WIN ? (wid & 3) : wid, whead = WIN ? (wid >> 2) : 0;
  const bf16* Qw = Qb + (long)(wrow * QBLK + r32) * LDQ + whead * 128 + hi * 8;
#pragma unroll
  for (int d0 = 0; d0 < 8; ++d0) qr[d0] = ld8(Qw + d0 * 16);
  int kb0 = 0, NT = seq / KVBLK;
  if (WIN) { int jlo = P0 / KVBLK - 2; if (jlo < 0) jlo = 0; int jhi = P0 / KVBLK + WROWS / KVBLK + 2; if (jhi > seq / KVBLK) jhi = seq / KVBLK; kb0 = jlo * KVBLK; NT = jhi - jlo; }
  unsigned oK[2], oV[2];
#pragma unroll
  for (int j = 0; j < 2; ++j) { const int q = 2 * wid + j;
    { const int row = 4 * q + (lane >> 4), cc = lane & 15, c = cc ^ (row & 7); oK[j] = (unsigned)(row * LDK + c * 8) * 2u; }
    { const int p = q * 64 + lane, st = p >> 5, pp = p & 31, kk = 8 * (st >> 2) + (pp >> 2), k = DYN ? ((kk & ~0xC) | ((kk & 4) << 1) | ((kk & 8) >> 1)) : kk, c = 32 * (st & 3) + 8 * (pp & 3);
      oV[j] = (unsigned)(k * LDK + c) * 2u; } }
  asm volatile("" : "+v"(oK[0]), "+v"(oK[1]), "+v"(oV[0]), "+v"(oV[1]));
  const char* Kt0 = (const char*)(Kh + (long)kb0 * LDK); const char* Vt0 = (const char*)(Vh + (long)kb0 * LDK);
  const lds_ptr dK = ring + wid * 2048, dV = ring + RING_V + wid * 2048;
#define AS1C const __attribute__((address_space(1))) char*
#define DMA(t) do { const int sl_ = ((t) & 3) * RING_SLOT; const long go_ = (long)(t) * KVBLK * LDK * 2; unsigned long long kb_ = (unsigned long long)(Kt0 + go_), vb_ = (unsigned long long)(Vt0 + go_); asm volatile("" : "+s"(kb_), "+s"(vb_)); AS1C kt_ = (AS1C)kb_; AS1C vt_ = (AS1C)vb_; \
    __builtin_amdgcn_global_load_lds((const __attribute__((address_space(1))) unsigned*)(kt_ + oK[0]), (__attribute__((address_space(3))) unsigned*)(dK + sl_), 16, 0, 0); \
    __builtin_amdgcn_global_load_lds((const __attribute__((address_space(1))) unsigned*)(kt_ + oK[1]), (__attribute__((address_space(3))) unsigned*)(dK + sl_ + 1024), 16, 0, 0); \
    __builtin_amdgcn_global_load_lds((const __attribute__((address_space(1))) unsigned*)(vt_ + oV[0]), (__attribute__((address_space(3))) unsigned*)(dV + sl_), 16, 0, 0); \
    __builtin_amdgcn_global_load_lds((const __attribute__((address_space(1))) unsigned*)(vt_ + oV[1]), (__attribute__((address_space(3))) unsigned*)(dV + sl_ + 1024), 16, 0, 0); } while (0)
#define DMA1(t, pc) do { const int sl_ = ((t) & 3) * RING_SLOT; const long go_ = (long)(t) * KVBLK * LDK * 2; unsigned long long b_ = (unsigned long long)(((pc) < 2 ? Kt0 : Vt0) + go_); asm volatile("" : "+s"(b_)); AS1C bt_ = (AS1C)b_; \
    if ((pc) == 0) __builtin_amdgcn_global_load_lds((const __attribute__((address_space(1))) unsigned*)(bt_ + oK[0]), (__attribute__((address_space(3))) unsigned*)(dK + sl_), 16, 0, 0); \
    if ((pc) == 1) __builtin_amdgcn_global_load_lds((const __attribute__((address_space(1))) unsigned*)(bt_ + oK[1]), (__attribute__((address_space(3))) unsigned*)(dK + sl_ + 1024), 16, 0, 0); \
    if ((pc) == 2) __builtin_amdgcn_global_load_lds((const __attribute__((address_space(1))) unsigned*)(bt_ + oV[0]), (__attribute__((address_space(3))) unsigned*)(dV + sl_), 16, 0, 0); \
    if ((pc) == 3) __builtin_amdgcn_global_load_lds((const __attribute__((address_space(1))) unsigned*)(bt_ + oV[1]), (__attribute__((address_space(3))) unsigned*)(dV + sl_ + 1024), 16, 0, 0); } while (0)
#define WAIT_BAR(N) asm volatile("s_waitcnt vmcnt(" #N ") lgkmcnt(0)\n\ts_barrier" ::: "memory")
  DMA(0); DMA(1);
  if (!WIN) {
    float qf[8][8]; float ss = 0.f;
#pragma unroll
    for (int d0 = 0; d0 < 8; ++d0)
#pragma unroll
      for (int i = 0; i < 8; ++i) { qf[d0][i] = __uint_as_float(((unsigned)(unsigned short)qr[d0][i]) << 16); ss += qf[d0][i] * qf[d0][i]; }
    { auto rr = __builtin_amdgcn_permlane32_swap(__float_as_uint(ss), __float_as_uint(ss), false, false); ss = __uint_as_float(rr[0]) + __uint_as_float(rr[1]); }
    const float rinv = __builtin_amdgcn_rsqf(ss * (1.f / 128.f) + 1e-6f) * (SCALE * LOG2E);
#pragma unroll
    for (int d0 = 0; d0 < 8; ++d0) { const f32x4v g0 = *(const f32x4v*)(qg + d0 * 16 + hi * 8), g1 = *(const f32x4v*)(qg + d0 * 16 + hi * 8 + 4);
#pragma unroll
      for (int i = 0; i < 4; ++i) { qf[d0][i] *= rinv * g0[i]; qf[d0][4 + i] *= rinv * g1[i]; } }
    const int qp = P0 + wid * QBLK + r32;
#pragma unroll
    for (int seg = 0; seg < 2; ++seg) { const int pos = seg == 0 ? (qp >> 6) : (qp & 63);
#pragma unroll
      for (int dd = 0; dd < 2; ++dd) { const int d0 = seg * 4 + dd; const float* tc = rope + pos * 32 + dd * 16 + hi * 8;
        const f32x4v c0 = *(const f32x4v*)tc, c1 = *(const f32x4v*)(tc + 4), s0 = *(const f32x4v*)(tc + 8192), s1 = *(const f32x4v*)(tc + 8192 + 4);
#pragma unroll
        for (int i = 0; i < 8; ++i) { const float c = i < 4 ? c0[i & 3] : c1[i & 3], s = i < 4 ? s0[i & 3] : s1[i & 3]; const float x1 = qf[d0][i], x2 = qf[d0 + 2][i];
          qf[d0][i] = x1 * c - x2 * s; qf[d0 + 2][i] = x2 * c + x1 * s; } } }
#pragma unroll
    for (int d0 = 0; d0 < 8; ++d0) { u32x4 w = {cvtpk(qf[d0][0], qf[d0][1]), cvtpk(qf[d0][2], qf[d0][3]), cvtpk(qf[d0][4], qf[d0][5]), cvtpk(qf[d0][6], qf[d0][7])}; qr[d0] = *reinterpret_cast<bf16x8*>(&w); }  }
  if (WIN) {
#pragma unroll
    for (int d0 = 0; d0 < 8; ++d0) { float t[8];
#pragma unroll
      for (int i = 0; i < 8; ++i) t[i] = __uint_as_float(((unsigned)(unsigned short)qr[d0][i]) << 16) * (SCALE * LOG2E);
      u32x4 w = {cvtpk(t[0], t[1]), cvtpk(t[2], t[3]), cvtpk(t[4], t[5]), cvtpk(t[6], t[7])}; qr[d0] = *reinterpret_cast<bf16x8*>(&w); } }
  lds_cptr kb4[4];
#pragma unroll
  for (int dd = 0; dd < 4; ++dd) kb4[dd] = (lds_cptr)ring + KSWZ(r32, (dd * 16 + hi * 8) * 2);
  const int vb0 = (int)(unsigned)(uintptr_t)(ring + RING_V) + v_rd_base(lane);
  const int qpos = P0 + wrow * QBLK + r32;
#define RESC(a) do { if ((WIN || dyn) && __any((a) < 1.f)) { if (hi == 0) al_l[r32] = (a); asm volatile("s_waitcnt lgkmcnt(0)" ::: "memory"); \
    for (int d = 0; d < 4; ++d) for (int r = 0; r < 16; ++r) o[d][r] *= al_l[crow(r, hi)]; } } while (0)
  const int qlo = P0 + wrow * QBLK;
#define ACT(t) (!WIN || (kb0 + (t) * KVBLK <= qlo + QBLK - 1 + 128 && kb0 + (t) * KVBLK + KVBLK - 1 >= qlo - 128))
#define QKT(PX0, PX1, t) do { if (ACT(t)) qkt_l<!DYN>(PX0, PX1, kb4, ((t) & 3) * RING_SLOT, qr, negm); } while (0)
#define PSM(P0_, P1_, mnX, alX, t) do { if (WIN) { if (ACT(t)) win_bias_tab(P0_, P1_, kb0 + (t) * KVBLK - qpos, (lds_cptr)ring + WLUT_OFF + whead * WTAB_BYTES, hi); } if (WIN || dyn) { if (ACT(t)) psm_next(P0_, P1_, negm, mref, alX); else alX = 1.f; } else { alX = 1.f; unsigned op_; asm volatile("s_mov_b32 %0, 1" : "=s"(op_)); if (op_) { _Pragma("unroll") for (int r_ = 0; r_ < 16; ++r_) P0_[r_] = __builtin_amdgcn_exp2f(P0_[r_]); } } } while (0)
  f32x16 pA0, pA1, pB0, pB1; float mnA, mnB, alA, alB; bf16x8 pa0, pa1, pa2, pa3;
  if (WIN) {
    __attribute__((address_space(3))) float* tw = (__attribute__((address_space(3))) float*)(ring + WLUT_OFF);
    for (int q = wid * 64 + lane; q < 2 * 4 * WCOPY; q += 512) { const int t_ = q / (4 * WCOPY), qq_ = q - t_ * (4 * WCOPY), s_ = qq_ / WCOPY, i_ = qq_ - s_ * WCOPY + s_ - 96; tw[q] = (unsigned)i_ <= 256u ? lut[t_ * WLUT_STRIDE + i_] : -__builtin_inff(); } }
  WAIT_BAR(4);
  SBAR(); QKT(pA0, pA1, 0); if (WIN) { if (ACT(0)) win_bias_tab(pA0, pA1, kb0 - qpos, (lds_cptr)ring + WLUT_OFF + whead * WTAB_BYTES, hi); } if (WIN || dyn) { if (ACT(0)) psm_start(pA0, pA1, negm, mref); } else { _Pragma("unroll") for (int r_ = 0; r_ < 16; ++r_) pA0[r_] = __builtin_amdgcn_exp2f(pA0[r_]); } alA = 1.f;
  if (2 < NT) { DMA(2); WAIT_BAR(4); } else { WAIT_BAR(0); }
#define HALF_STEP(PX0, PX1, mnX, alX, PY0, PY1, alY, t) do { \
    if ((t) + 2 < NT) DMA((t) + 2); \
    SBAR(); QKT(PX0, PX1, t); \
    if (ACT((t) - 1)) { finishSM<!DYN>(PY0, PY1, alY, l_reg, pa0, pa1, pa2, pa3); SBAR(); \
      pv_d0(o, vb0 + (((t) - 1) & 3) * RING_SLOT, pa0, pa1, pa2, pa3); } PSM(PX0, PX1, mnX, alX, t); \
    RESC(alX); \
    if ((t) + 2 < NT) WAIT_BAR(4); else WAIT_BAR(0); } while (0)
  typedef float f2_t __attribute__((ext_vector_type(2)));
#define KLD(i, KS_) do { if (((i) & 1) == 0) { if (((i) >> 3) == 0) k_rda<0 + (KS_) * RING_SLOT>(kf[(i) & 3], kbi_[((i) >> 1) & 3]); else k_rda<128 + (KS_) * RING_SLOT>(kf[(i) & 3], kbi_[((i) >> 1) & 3]); } \
                           else { if (((i) >> 3) == 0) k_rda<8192 + (KS_) * RING_SLOT>(kf[(i) & 3], kbi_[((i) >> 1) & 3]); else k_rda<8320 + (KS_) * RING_SLOT>(kf[(i) & 3], kbi_[((i) >> 1) & 3]); } } while (0)
#define VLD(j, VS_) do { vlo[(j) & 3] = tr_read<v_rd_off((j) & 3, (j) >> 2, 0) + (VS_) * RING_SLOT>(vb0); vhi[(j) & 3] = tr_read<v_rd_off((j) & 3, (j) >> 2, 1) + (VS_) * RING_SLOT>(vb0); } while (0)
#define VFR(j) (bf16x8){vlo[(j) & 3][0], vlo[(j) & 3][1], vlo[(j) & 3][2], vlo[(j) & 3][3], vhi[(j) & 3][0], vhi[(j) & 3][1], vhi[(j) & 3][2], vhi[(j) & 3][3]}
#define KWAIT(i) do { if ((i) <= 12) k_wt<3>(kf[(i) & 3]); else if ((i) == 13) k_wt<4>(kf[(i) & 3]); else if ((i) == 14) k_wt<5>(kf[(i) & 3]); else k_wt<6>(kf[(i) & 3]); } while (0)
#define VWAIT(j) do { if ((j) <= 12) v_wt<6>(vlo[(j) & 3], vhi[(j) & 3]); else if ((j) == 13) v_wt<4>(vlo[(j) & 3], vhi[(j) & 3]); else if ((j) == 14) v_wt<2>(vlo[(j) & 3], vhi[(j) & 3]); else v_wt<0>(vlo[(j) & 3], vhi[(j) & 3]); } while (0)
#define G1(i, X, Y0_, Y1_, koff_, vp_) do { \
    KWAIT(i); X = __builtin_amdgcn_mfma_f32_32x32x16_bf16(kf[(i) & 3], qr[(i) >> 1], (i) < 2 ? f32x16{} : X, 0, 0, 0); \
    if ((i) + 4 < 16) KLD((i) + 4, koff_); \
    Y1_[i] = __builtin_amdgcn_exp2f(Y1_[i]); \
    sacc = fadd_s(sacc, Y0_[i]); \
    if ((i) < 8) { pw[(i) >> 2][(i) & 3] = cvtpk(Y0_[2 * (i)], Y0_[2 * (i) + 1]); } \
    else { pw[(i) >> 2][(i) & 3] = cvtpk(Y1_[2 * ((i) - 8)], Y1_[2 * ((i) - 8) + 1]); } \
    if ((i) >= 12) VLD((i) - 12, vp_); \
    SBAR(); } while (0)
#define G2(j, X0_, Y1_, vp_, tt) do { \
    VWAIT(j); o[(j) & 3] = __builtin_amdgcn_mfma_f32_32x32x16_bf16(__builtin_bit_cast(bf16x8, pw[(j) >> 2]), VFR(j), o[(j) & 3], 0, 0, 0); \
    if ((j) + 4 < 16) VLD((j) + 4, vp_); \
    X0_[j] = __builtin_amdgcn_exp2f(X0_[j]); asm volatile("" : "+v"(X0_[j])); \
    if ((j) >= 2 && (j) < 6) { if ((tt) + 2 < NT) DMA1((tt) + 2, (j) - 2); } \
    sacc = fadd_s(sacc, Y1_[j]); \
    SBAR(); } while (0)
#define STEP_G(PX0, PX1, PY0, PY1, t, koff_, vp_) do {     \
    bf16x8 kf[4]; s16x4 vlo[4], vhi[4]; u32x4 pw[4]; float sacc = ATT_DEFER_L ? l_reg : 0.f; \
    SBAR(); KLD(0, koff_); KLD(1, koff_); KLD(2, koff_); KLD(3, koff_); SBAR(); \
    G1(0, PX0, PY0, PY1, koff_, vp_); G1(1, PX1, PY0, PY1, koff_, vp_); G1(2, PX0, PY0, PY1, koff_, vp_); G1(3, PX1, PY0, PY1, koff_, vp_); \
    G1(4, PX0, PY0, PY1, koff_, vp_); G1(5, PX1, PY0, PY1, koff_, vp_); G1(6, PX0, PY0, PY1, koff_, vp_); G1(7, PX1, PY0, PY1, koff_, vp_); \
    G1(8, PX0, PY0, PY1, koff_, vp_); G1(9, PX1, PY0, PY1, koff_, vp_); G1(10, PX0, PY0, PY1, koff_, vp_); G1(11, PX1, PY0, PY1, koff_, vp_); \
    G1(12, PX0, PY0, PY1, koff_, vp_); G1(13, PX1, PY0, PY1, koff_, vp_); G1(14, PX0, PY0, PY1, koff_, vp_); G1(15, PX1, PY0, PY1, koff_, vp_); \
    G2(0, PX0, PY1, vp_, t); G2(1, PX0, PY1, vp_, t); G2(2, PX0, PY1, vp_, t); G2(3, PX0, PY1, vp_, t); \
    G2(4, PX0, PY1, vp_, t); G2(5, PX0, PY1, vp_, t); G2(6, PX0, PY1, vp_, t); G2(7, PX0, PY1, vp_, t); \
    G2(8, PX0, PY1, vp_, t); G2(9, PX0, PY1, vp_, t); G2(10, PX0, PY1, vp_, t); G2(11, PX0, PY1, vp_, t); \
    G2(12, PX0, PY1, vp_, t); G2(13, PX0, PY1, vp_, t); G2(14, PX0, PY1, vp_, t); G2(15, PX0, PY1, vp_, t); \
    if (ATT_DEFER_L) l_reg = sacc; else { float ps = sacc; auto rr = __builtin_amdgcn_permlane32_swap(__float_as_uint(ps), __float_as_uint(ps), false, false); l_reg += __uint_as_float(rr[0]) + __uint_as_float(rr[1]); } \
    if ((t) + 2 < NT) WAIT_BAR(4); else WAIT_BAR(0); } while (0)
  if constexpr (!DYN) {
    int kbi_[4];
#pragma unroll
    for (int dd_ = 0; dd_ < 4; ++dd_) kbi_[dd_] = (int)(unsigned)(uintptr_t)kb4[dd_];
    int j = 1;
#pragma nounroll
    for (; j + 4 < NT; j += 4) { STEP_G(pB0, pB1, pA0, pA1, j, 1, 0); STEP_G(pA0, pA1, pB0, pB1, j + 1, 2, 1); STEP_G(pB0, pB1, pA0, pA1, j + 2, 3, 2); STEP_G(pA0, pA1, pB0, pB1, j + 3, 0, 3); }
    if (j + 1 < NT) { STEP_G(pB0, pB1, pA0, pA1, j, 1, 0); STEP_G(pA0, pA1, pB0, pB1, j + 1, 2, 1); }
  } else {
#pragma nounroll
    for (int j = 1; j + 1 < NT; j += 2) { HALF_STEP(pB0, pB1, mnB, alB, pA0, pA1, alA, j); HALF_STEP(pA0, pA1, mnA, alA, pB0, pB1, alB, j + 1); }
  }
  SBAR(); QKT(pB0, pB1, NT - 1);
  if (ACT(NT - 2)) { finishSM<!DYN>(pA0, pA1, alA, l_reg, pa0, pa1, pa2, pa3); SBAR();
    pv_d0(o, vb0 + ((NT - 2) & 3) * RING_SLOT, pa0, pa1, pa2, pa3); } PSM(pB0, pB1, mnB, alB, NT - 1);
  RESC(alB);
  if (ACT(NT - 1)) { finishSM<!DYN>(pB0, pB1, alB, l_reg, pa0, pa1, pa2, pa3); SBAR();
    pv_d0(o, vb0 + ((NT - 1) & 3) * RING_SLOT, pa0, pa1, pa2, pa3); }
  if (!DYN && ATT_DEFER_L) { auto rr = __builtin_amdgcn_permlane32_swap(__float_as_uint(l_reg), __float_as_uint(l_reg), false, false); l_reg = __uint_as_float(rr[0]) + __uint_as_float(rr[1]); }
  if (WIN) l_reg += __builtin_amdgcn_exp2f(sink2 - mref);
  if (hi == 0) li_l[r32] = l_reg; asm volatile("s_waitcnt lgkmcnt(0)" ::: "memory");
  float rli[16];
#pragma unroll
  for (int r = 0; r < 16; ++r) rli[r] = __builtin_amdgcn_rcpf(li_l[crow(r, hi)]);
  bf16* Ow = Ob + (long)(wrow * QBLK) * LDO + whead * 128 + (r32 & ~1) + ((r32 & 1) ? 32 : 0);
  const bool odd = (r32 & 1) != 0;
#define DPPF(v, ctrl) __builtin_bit_cast(float, __builtin_amdgcn_mov_dpp(__builtin_bit_cast(int, (v)), (ctrl), 0xF, 0xF, true))
#pragma unroll
  for (int r = 0; r < 16; ++r) { const int orow = crow(r, hi); float sq = 0.f;
#pragma unroll
    for (int dp = 0; dp < 2; ++dp) { const float va = o[2 * dp][r] * rli[r], vb = o[2 * dp + 1][r] * rli[r]; sq += va * va; sq += vb * vb;
      const float x = odd ? va : vb, y = DPPF(x, 0xB1);
      *(unsigned*)(Ow + (long)orow * LDO + dp * 64) = odd ? cvtpk(y, vb) : cvtpk(va, y); }
    sq += DPPF(sq, 0xB1); sq += DPPF(sq, 0x4E); sq += DPPF(sq, 0x141); sq += DPPF(sq, 0x140);
    sq += __builtin_bit_cast(float, __builtin_amdgcn_update_dpp(0, __builtin_bit_cast(int, sq), 0x142, 0xA, 0xF, false));
    if (r32 == 16) sso[16 * (size_t)(wrow * QBLK + orow) + whead] = sq; }
#undef DPPF
  WAIT_BAR(0);
#undef DMA
#undef WAIT_BAR
#undef RESC
#undef PSM
#undef HALF_STEP
#undef STEP_G
#undef G1
#undef G2
#undef KLD
#undef VLD
#undef VFR
#undef KWAIT
#undef VWAIT
#undef DMA1
#undef AS1C
#undef ACT
#undef QKT
}
#undef KSWZ
#undef SBAR
}
#define GAS __attribute__((address_space(1)))
#define LAS __attribute__((address_space(3)))
typedef unsigned short bf16;
typedef unsigned v4u __attribute__((ext_vector_type(4)));
typedef float f32x4 __attribute__((ext_vector_type(4)));
typedef short bf16x8 __attribute__((ext_vector_type(8)));
typedef GAS unsigned gu32;
typedef GAS unsigned long long gu64;
#define RLX_AGENT __ATOMIC_RELAXED, __HIP_MEMORY_SCOPE_AGENT
#define LDS_WAIT() asm volatile("s_waitcnt lgkmcnt(0)" ::: "memory")
#define VM_WAIT() asm volatile("s_waitcnt vmcnt(0)" ::: "memory")
__device__ __forceinline__ unsigned long long rt() { return __builtin_amdgcn_s_memrealtime(); }
__device__ __forceinline__ unsigned f2bf(float f) { unsigned u = __builtin_bit_cast(unsigned, f); return (u + 0x7fffu + ((u >> 16) & 1u)) >> 16; }
__device__ __forceinline__ unsigned pk2(float lo, float hi) { return f2bf(lo) | (f2bf(hi) << 16); }

#define XB_TMO      128
#define XB_XCNT(j)  (256  + 64 * (j))
#define XB_XSUB(j)  (1280 + 64 * (j))
#define XB_XGEN(j)  (2304 + 64 * (j))
#define XB_TOP      3328
#define XB_TOPGEN   3392
#define XL_SUB(j)   (3456 + 64 * (j))
#define XL_GEN(j)   (4480 + 64 * (j))
#define XCD_BAR_WORDS 5504
#define XB_SPIN_CAP (1u << 18)

__device__ __forceinline__ unsigned xb_ld(unsigned* p)              { return __hip_atomic_load(p, __ATOMIC_RELAXED, __HIP_MEMORY_SCOPE_AGENT); }
__device__ __forceinline__ unsigned xb_add(unsigned* p, unsigned v) { return __hip_atomic_fetch_add(p, v, __ATOMIC_RELAXED, __HIP_MEMORY_SCOPE_AGENT); }
__device__ __forceinline__ unsigned xb_xcc_id() { return (unsigned)__builtin_amdgcn_s_getreg((3 << 11) | 20) & 0xFu; }
#define XB_SPIN(cond, bar) do { unsigned _sp = 0; while (cond) { __builtin_amdgcn_s_sleep(1); \
    if ((++_sp & 255u) == 0u) { if (xb_ld(&(bar)[XB_TMO])) break; if (_sp > XB_SPIN_CAP) { atomicAdd(&(bar)[XB_TMO], 1u); break; } } } } while (0)

__device__ __forceinline__ int lane_now() { int l; asm volatile("v_mbcnt_lo_u32_b32 %0, -1, 0\n\tv_mbcnt_hi_u32_b32 %0, -1, %0" : "=v"(l)); return l; }
struct XcdBarrier {
    unsigned w;
    unsigned* bar; unsigned x;
    volatile LAS unsigned* st;
};

__device__ __forceinline__ XcdBarrier xcd_barrier_post(unsigned* bar, volatile LAS unsigned* st) {
    XcdBarrier b; b.bar = bar; b.x = xb_xcc_id(); b.st = st; b.w = (unsigned)__builtin_amdgcn_readfirstlane((int)threadIdx.x >> 6);
    if (threadIdx.x == 0) st[2] = xb_add(&bar[XB_XCNT(b.x)], 1u);
    return b;
}
__device__ __forceinline__ void xcd_barrier_complete(unsigned* bar, unsigned x, unsigned& nloc, unsigned& nx, unsigned& uni) {
    const unsigned G = gridDim.x * gridDim.y * gridDim.z;
    unsigned sum, cnt, mine, sp = 0u;
    for (;;) {
        sum = 0u; cnt = 0u; mine = 0u;
        unsigned bad = 0u;
#pragma unroll
        for (unsigned j = 0; j < 16; ++j) { const unsigned c = xb_ld(&bar[XB_XCNT(j)]); sum += c; cnt += (c > 0u) ? 1u : 0u; mine = (j == x) ? c : mine; bad |= (j < 8u) ? (unsigned)(c * 8u != G) : (unsigned)(c != 0u); }
        uni = bad ? 0u : 1u;
        if (sum == G) break;
        __builtin_amdgcn_s_sleep(1);
        if ((++sp & 255u) == 0u) { if (xb_ld(&bar[XB_TMO])) break; if (sp > XB_SPIN_CAP) { atomicAdd(&bar[XB_TMO], 1u); break; } }
    }
    nloc = mine > 0u ? mine : 1u; nx = cnt > 0u ? cnt : 1u;
}

__device__ __forceinline__ void xcd_barrier(const XcdBarrier& b) {
    asm volatile("s_waitcnt vmcnt(0)" ::: "memory");
    __syncthreads();
    if (b.w == 0u && lane_now() == 0) {
        unsigned* bar = b.bar;
        __builtin_amdgcn_s_waitcnt(0);
        unsigned nloc = b.st[0], nx = b.st[1];
        if (nloc == 0u) { unsigned uni = 0u; xcd_barrier_complete(bar, b.x, nloc, nx, uni); b.st[0] = nloc; b.st[1] = nx; b.st[3] = uni; }
        const unsigned old = xb_add(&bar[XB_XSUB(b.x)], 1u);
        const unsigned gen = old / nloc;
        if (old + 1u == (gen + 1u) * nloc) {
            __builtin_amdgcn_fence(__ATOMIC_RELEASE, "agent");
            asm volatile("s_waitcnt vmcnt(0)" ::: "memory");
            const unsigned og = xb_add(&bar[XB_TOP], 1u);
            const unsigned tg = og / nx;
            if (og + 1u == (tg + 1u) * nx) xb_add(&bar[XB_TOPGEN], 1u);
            else XB_SPIN(xb_ld(&bar[XB_TOPGEN]) == tg, bar);
            __builtin_amdgcn_fence(__ATOMIC_ACQUIRE, "agent");
            xb_add(&bar[XB_XGEN(b.x)], 1u);
            asm volatile("s_waitcnt vmcnt(0)" ::: "memory");
        } else {
            XB_SPIN(xb_ld(&bar[XB_XGEN(b.x)]) == gen, bar);
            __builtin_amdgcn_fence(__ATOMIC_ACQUIRE, "agent");
            asm volatile("s_waitcnt vmcnt(0)" ::: "memory");
        }
    }
    __syncthreads();
}
__device__ __forceinline__ void xcd_local_barrier(const XcdBarrier& b) {
    asm volatile("s_waitcnt vmcnt(0)" ::: "memory");
    __syncthreads();
    if (b.w == 0u && lane_now() == 0) {
        unsigned* bar = b.bar;
        __builtin_amdgcn_s_waitcnt(0);
        const unsigned nloc = b.st[0];
        const unsigned old = xb_add(&bar[XL_SUB(b.x)], 1u);
        const unsigned gen = old / nloc;
        if (old + 1u == (gen + 1u) * nloc) xb_add(&bar[XL_GEN(b.x)], 1u);
        else XB_SPIN(xb_ld(&bar[XL_GEN(b.x)]) == gen, bar);
        __builtin_amdgcn_fence(__ATOMIC_ACQUIRE, "agent");
        asm volatile("s_waitcnt vmcnt(0)" ::: "memory");
    }
    __syncthreads();
}
#ifndef PG8_SP2
#define PG8_SP2 true
#endif
constexpr int NWAVES = 8;
constexpr int DM = 2048, DEPTH = 4, NIN = 3072, DFF = 8192, MODW = 6 * DM;
constexpr int T0 = 16384, T1 = 8192;
constexpr int M = T0 + 2 * T1;
constexpr float EPS = 1e-6f;
constexpr float LOG2E = 1.4426950408889634f;

constexpr size_t MiB = 1u << 20;
constexpr size_t WS_CTL = 0, CTL_ZERO_BYTES = 128 * 1024;
constexpr size_t WS_MOD = 1 * MiB;
constexpr size_t WS_ROPE = 2 * MiB;
constexpr size_t WS_GV = 3 * MiB;
constexpr size_t WS_BV = 4 * MiB;
constexpr size_t BV_UP = (size_t)DEPTH * 3 * NIN * 4;
constexpr size_t WS_SSP = 6 * MiB;
constexpr size_t WS_SSOP = 10 * MiB;
constexpr size_t WS_W = 12 * MiB, W_LAYER = 84 * MiB;
constexpr size_t W_IN = 0, W_OUT = 12 * MiB, W_UP = 20 * MiB, W_DOWN = 52 * MiB;
constexpr size_t WS_XN = WS_W + DEPTH * W_LAYER;
constexpr size_t WS_QKV = WS_XN + 128 * MiB;
constexpr size_t WS_O = WS_QKV + 192 * MiB;
constexpr size_t WS_H = WS_O + 128 * MiB;
constexpr size_t WS_XB = WS_H + 512 * MiB;
constexpr size_t WS_END = WS_XB + 128 * MiB;
constexpr int CW_BAR = 4096, CW_WQ = 16384;
static_assert((size_t)(CW_BAR + XCD_BAR_WORDS) * 4 <= CTL_ZERO_BYTES && (size_t)(CW_WQ + 64 * 4) * 4 <= CTL_ZERO_BYTES, "every control word lies inside the per-call memset");
static_assert((size_t)M * 8 * 4 <= 4 * MiB && (size_t)M * 16 * 4 <= 2 * MiB && BV_UP + (size_t)DEPTH * 3 * DFF * 4 <= 2 * MiB, "d_ws map");

constexpr int RING_OFF = 0, RING_BYTES = 131072;
constexpr int LDSCTL_OFF = RING_BYTES, MISC_OFF = LDSCTL_OFF + 320;
constexpr int LUT_OFF = LDSCTL_OFF + 512, LUT_STRIDE = 260;
constexpr int TAB_OFF = LUT_OFF + 8 * LUT_STRIDE * 4;
constexpr int AWS_OFF = TAB_OFF + 256 * 8;
constexpr int VEC_OFF = AWS_OFF + 256 * 4 * 4;
constexpr int WLUT_OFF = att::WLUT_OFF;
constexpr int LDS_BYTES = att::WLUT_OFF + 2 * att::WTAB_BYTES;
static_assert(att::WLUT_OFF == VEC_OFF && LUT_STRIDE == att::WLUT_STRIDE && LDS_BYTES <= 163840, "window tables reuse the GEMM epilogues' vector area (idle during the attention phase) and what lies behind it");
static_assert(TAB_OFF % 16 == 0 && AWS_OFF % 16 == 0 && VEC_OFF + 2 * 256 * 4 <= LDS_BYTES, "LDS map");

struct Args { const float* in[19]; float* out; unsigned char* ws; };

__device__ __forceinline__ float wave_sum(float v) {
#define WS_DPP(x, ctrl) __builtin_bit_cast(float, __builtin_amdgcn_mov_dpp(__builtin_bit_cast(int, (x)), (ctrl), 0xF, 0xF, true))
    v += WS_DPP(v, 0xB1); v += WS_DPP(v, 0x4E); v += WS_DPP(v, 0x141); v += WS_DPP(v, 0x140);
#undef WS_DPP
    { auto r = __builtin_amdgcn_permlane16_swap(__float_as_uint(v), __float_as_uint(v), false, false); v = __uint_as_float(r[0]) + __uint_as_float(r[1]); }
    { auto r = __builtin_amdgcn_permlane32_swap(__float_as_uint(v), __float_as_uint(v), false, false); v = __uint_as_float(r[0]) + __uint_as_float(r[1]); }
    return v;
}
__device__ __forceinline__ float bf_lo(unsigned w) { return __builtin_bit_cast(float, w << 16); }
__device__ __forceinline__ float bf_hi(unsigned w) { return __builtin_bit_cast(float, w & 0xffff0000u); }
__device__ __forceinline__ int seq_of_row(int m) { return m < T0 ? 0 : (m < T0 + T1 ? 1 : 2); }
__device__ __forceinline__ int seq_start(int s) { return s == 0 ? 0 : (s == 1 ? T0 : T0 + T1); }

__device__ __forceinline__ void p0_transpose_item(const float* W, int K, int N, bf16* WT, LAS float* scr, int item, int lane, const float* kg) {
    const int nblk = N / 32, kb = item / nblk, nb = item % nblk, k0 = 128 * kb, n0 = 32 * nb;
#pragma unroll
    for (int i = 0; i < 64; ++i) { const int kk = 2 * i + (lane >> 5); const float g = kg ? kg[k0 + kk] : 1.f; scr[kk * 32 + (((lane & 31) + 2 * (kk >> 3)) & 31)] = __builtin_nontemporal_load(W + (size_t)(k0 + kk) * N + n0 + (lane & 31)) * g; }
    LDS_WAIT(); asm volatile("" ::: "memory");
    const int c = lane & 15;
#pragma unroll
    for (int j = 0; j < 8; ++j) { const int n = (lane >> 4) + 4 * j; const LAS float* s = scr + (8 * c) * 32 + ((n + 2 * c) & 31);
        v4u o; o.x = pk2(s[0 * 32], s[1 * 32]); o.y = pk2(s[2 * 32], s[3 * 32]); o.z = pk2(s[4 * 32], s[5 * 32]); o.w = pk2(s[6 * 32], s[7 * 32]);
        *(GAS v4u*)(WT + (size_t)(n0 + n) * K + k0 + 8 * c) = o; }
    LDS_WAIT(); asm volatile("" ::: "memory");
}

template <int IDX> __device__ __forceinline__ const float* kin() {
    unsigned long long v; asm volatile("s_load_dwordx2 %0, %1, %2\n\ts_waitcnt lgkmcnt(0)" : "=s"(v) : "s"(__builtin_amdgcn_kernarg_segment_ptr()), "n"(IDX * 8)); return (const float*)(const GAS float*)v; }
#define KIN(i) kin<(i)>()
#define OUTP() ((float*)kin<19>())
#define WSP() ((unsigned char*)kin<20>())
#define P_SSP() ((float*)(WSP() + WS_SSP))
#define P_SSOP() ((float*)(WSP() + WS_SSOP))
#define P_TAB() ((PG8_LAS pg8::f32x2*)(ldsl + TAB_OFF))
#define P_MOD() ((float*)(WSP() + WS_MOD))
#define P_ROPE() ((float*)(WSP() + WS_ROPE))
#define P_GV(hl) ((float*)(WSP() + WS_GV) + (size_t)(hl) * 3 * DM)
#define P_BV(l, mlp) ((float*)(WSP() + WS_BV + ((mlp) ? BV_UP : 0)) + (size_t)(l) * 3 * ((mlp) ? DFF : NIN))
#define P_XN() ((bf16*)(WSP() + WS_XN))
#define P_QKV() ((bf16*)(WSP() + WS_QKV))
#define P_O() ((bf16*)(WSP() + WS_O))
#define P_H() ((bf16*)(WSP() + WS_H))
#define P_XB() ((bf16*)(WSP() + WS_XB))
template <int BYTE> __device__ __forceinline__ int lds_word_now() { int v; asm volatile("v_mov_b32 %0, %1\n\tds_read_b32 %0, %0\n\ts_waitcnt lgkmcnt(0)" : "=v"(v) : "n"(BYTE) : "memory"); return __builtin_amdgcn_readfirstlane(v); }
#define XL_ON() (lds_word_now<MISC_OFF + 44>() != 0)
#define XL_RANK() lds_word_now<MISC_OFF + 40>()
#define CU_SLOT() (XL_ON() ? (int)bar.x + 8 * XL_RANK() : bx)
#define LAUNDER_LANE() const int lane = lane_now()

__global__ void __launch_bounds__(NWAVES * 64, 2) fwd_kernel(Args args) {
    extern __shared__ __attribute__((aligned(16))) unsigned char lds[];
    LAS unsigned char* ldsl = (LAS unsigned char*)lds;
    volatile LAS unsigned* MISC = (volatile LAS unsigned*)(ldsl + MISC_OFF);
    const int wave = __builtin_amdgcn_readfirstlane((int)threadIdx.x >> 6);
    const int G = gridDim.x; const int bx = blockIdx.x;
    const int vcu = (G % 8 == 0) ? (bx % 8) * (G / 8) + bx / 8 : bx;
    const int gw = vcu * NWAVES + wave, NGW = G * NWAVES;

    for (int u = threadIdx.x; u < (LUT_OFF - LDSCTL_OFF) / 4; u += NWAVES * 64) ((LAS unsigned*)(ldsl + LDSCTL_OFF))[u] = 0u;
    __syncthreads();
    XcdBarrier bar = xcd_barrier_post((unsigned*)((gu32*)(WSP() + WS_CTL) + CW_BAR), MISC + 8);
#define GRID_BAR() do { XcdBarrier b_ = bar; unsigned long long p_ = (unsigned long long)bar.bar; asm volatile("" : "+s"(p_), "+s"(b_.x)); b_.bar = (unsigned*)(GAS unsigned*)p_; xcd_barrier(b_); } while (0)
#define SEAM_BAR(local) do { XcdBarrier b_ = bar; unsigned long long p_ = (unsigned long long)bar.bar; asm volatile("" : "+s"(p_), "+s"(b_.x)); b_.bar = (unsigned*)(GAS unsigned*)p_; if (local) xcd_local_barrier(b_); else xcd_barrier(b_); } while (0)

    {
    {   LAUNDER_LANE(); const int tid = wave * 64 + lane;
        { float* lutw = (float*)(lds + LUT_OFF); const float* rel_bias = KIN(17);
          for (int i = tid; i < 8 * 257; i += NWAVES * 64) { const int h = i / 257, ri = i % 257, rel = ri - 128, n = rel < 0 ? -rel : rel;
              int bk; if (n < 8) bk = n; else { int lg = (31 - __builtin_clz(n * n)) - 6 + 8; bk = lg > 15 ? 15 : lg; }
              if (rel > 0) bk += 16;
              lutw[h * LUT_STRIDE + ri] = rel_bias[bk * 8 + h] * LOG2E; } }
        { const int gid = vcu * (NWAVES * 64) + tid;
          if (gid < 256 * 32) { const int p = gid >> 5, j = gid & 31;
              double f = 1.0; for (int i = 0; i < j; ++i) f *= 0.74989420933245582730;
              const float ang = (float)p * (float)f;
              const double rev = (double)ang * 0.15915494309189533577; const double fr = rev - __builtin_rint(rev); const double xx = fr * 6.28318530717958647693, x2 = xx * xx;
              double sn = 1.0, cs = 1.0;
              for (int k = 14; k >= 1; --k) { sn = 1.0 - sn * x2 / (double)((2 * k) * (2 * k + 1)); cs = 1.0 - cs * x2 / (double)((2 * k - 1) * (2 * k)); }
              P_ROPE()[gid] = (float)cs; P_ROPE()[256 * 32 + gid] = (float)(xx * sn); } }
        { LAS float* scr = (LAS float*)(ldsl + RING_OFF + wave * 16384);
          constexpr int I_IN = (DM / 128) * (NIN / 32), I_OUT = (DM / 128) * (DM / 32), I_UP = (DM / 128) * (DFF / 32), I_DN = (DFF / 128) * (DM / 32), I_L = I_IN + I_OUT + I_UP + I_DN;
          for (int it = gw; it < DEPTH * I_L; it += NGW) { const int l = it / I_L; int r = it % I_L; unsigned char* wl = WSP() + WS_W + (size_t)l * W_LAYER;
              if (r < I_IN) { p0_transpose_item(KIN(7) + (size_t)l * DM * NIN, DM, NIN, (bf16*)(wl + W_IN), scr, r, lane, nullptr); continue; } r -= I_IN;
              if (r < I_OUT) { const int kb = r / (DM / 32);
                  p0_transpose_item(KIN(13) + (size_t)l * DM * DM, DM, DM, (bf16*)(wl + W_OUT), scr, r, lane, kb < 8 ? KIN(11) + l * 1024 : KIN(12) + l * 1024 - 1024); continue; } r -= I_OUT;
              if (r < I_UP) { p0_transpose_item(KIN(15) + (size_t)l * DM * DFF, DM, DFF, (bf16*)(wl + W_UP), scr, r, lane, nullptr); continue; } r -= I_UP;
              p0_transpose_item(KIN(16) + (size_t)l * DFF * DM, DFF, DM, (bf16*)(wl + W_DOWN), scr, r, lane, nullptr); } }
        __syncthreads();
        { float* scv = (float*)lds; float* part = (float*)(lds + 32768); const float* c_prompt = KIN(2); const float* c_sample = KIN(3);
          for (int i = tid; i < 3 * DM; i += NWAVES * 64) { const int s = i / DM, d = i % DM; const float c = s == 0 ? c_prompt[d] : c_sample[(s - 1) * DM + d]; scv[i] = c / (1.f + __expf(-c)); }
          __syncthreads();
          for (int grp = vcu; grp < DEPTH * (MODW / 64); grp += G) { const int l = grp / (MODW / 64), e0 = (grp % (MODW / 64)) * 64;
              const float* w = KIN(4) + (size_t)l * DM * MODW + e0 + lane; float a0 = 0.f, a1 = 0.f, a2 = 0.f; const int d0 = wave * 256;
#pragma unroll 32
              for (int d = d0; d < d0 + 256; ++d) { const float wv = __builtin_nontemporal_load(w + (size_t)d * MODW); a0 = fmaf(scv[d], wv, a0); a1 = fmaf(scv[DM + d], wv, a1); a2 = fmaf(scv[2 * DM + d], wv, a2); }
              part[(wave * 3 + 0) * 64 + lane] = a0; part[(wave * 3 + 1) * 64 + lane] = a1; part[(wave * 3 + 2) * 64 + lane] = a2;
              __syncthreads();
              if (tid < 192) { const int s = tid >> 6, ln = tid & 63, e = e0 + ln; float acc = KIN(5)[l * MODW + e];
#pragma unroll
                  for (int w8 = 0; w8 < 8; ++w8) acc += part[(w8 * 3 + s) * 64 + ln];
                  P_MOD()[(size_t)(l * 3 + s) * MODW + e] = acc;
                  const int chunk = e / DM, k = e % DM;
                  if (chunk == 1) P_GV(2 * l)[s * DM + k] = KIN(6)[l * DM + k] * (1.f + acc);
                  if (chunk == 4) P_GV(2 * l + 1)[s * DM + k] = KIN(14)[l * DM + k] * (1.f + acc); }
              __syncthreads(); } }
    }
    GRID_BAR();
    {   LAUNDER_LANE(); const int tid = wave * 64 + lane;
        float* shv = (float*)lds;
        for (int cb = 0; cb < 2 * DEPTH; ++cb) { const int l = cb >> 1, mlp = cb & 1, N = mlp ? DFF : NIN;
            const float* sh = P_MOD() + (size_t)l * 3 * MODW + (mlp ? 3 * DM : 0);
            for (int i = tid; i < 3 * DM; i += NWAVES * 64) shv[i] = sh[(i / DM) * MODW + (i % DM)];
            __syncthreads();
            const bf16* Wt = (const bf16*)(WSP() + WS_W + (size_t)l * W_LAYER + (mlp ? W_UP : W_IN)); float* bvo = P_BV(l, mlp);
            for (int n0 = gw; n0 < N; n0 += 2 * NGW) {
                v4u w[2][4];
#pragma unroll
                for (int u = 0; u < 2; ++u) { const int n = n0 + u * NGW < N ? n0 + u * NGW : n0;
#pragma unroll
                    for (int j = 0; j < 4; ++j) w[u][j] = *(const v4u*)(Wt + (size_t)n * DM + 8 * lane + 512 * j); }
#pragma unroll
                for (int u = 0; u < 2; ++u) { const int n = n0 + u * NGW; float a0 = 0.f, a1 = 0.f, a2 = 0.f;
#pragma unroll
                    for (int j = 0; j < 4; ++j) { const int k = 8 * lane + 512 * j;
#pragma unroll
                        for (int e = 0; e < 4; ++e) { const float w0 = bf_lo(w[u][j][e]), w1 = bf_hi(w[u][j][e]); const int kk = k + 2 * e;
                            a0 = fmaf(shv[kk], w0, a0); a0 = fmaf(shv[kk + 1], w1, a0); a1 = fmaf(shv[DM + kk], w0, a1); a1 = fmaf(shv[DM + kk + 1], w1, a1);
                            a2 = fmaf(shv[2 * DM + kk], w0, a2); a2 = fmaf(shv[2 * DM + kk + 1], w1, a2); } }
                    a0 = wave_sum(a0); a1 = wave_sum(a1); a2 = wave_sum(a2);
                    if (lane == 0 && n < N) { bvo[n] = a0; bvo[N + n] = a1; bvo[2 * N + n] = a2; } } }
            __syncthreads(); }
        { const float* xb0 = KIN(0); const float* xb1 = KIN(1); const float* gv0 = P_GV(0); bf16* XN = P_XN(); bf16* XB = P_XB(); float* ssp = P_SSP();
          for (int m = gw; m < M; m += NGW) {
              const int s = seq_of_row(m); const float* xr = m < T0 ? xb0 + (size_t)m * DM : xb1 + (size_t)(m - T0) * DM; const float* gv = gv0 + s * DM;
              float ss = 0.f;
#pragma unroll
              for (int j = 0; j < 8; ++j) { const int c = 4 * lane + 256 * j; const f32x4 v = __builtin_nontemporal_load((const f32x4*)(xr + c)); ss += (v.x * v.x + v.y * v.y) + (v.z * v.z + v.w * v.w);
                  const f32x4 o = v * *(const f32x4*)(gv + c);
                  *(unsigned long long*)(XN + (size_t)m * DM + c) = (unsigned long long)pk2(o.x, o.y) | ((unsigned long long)pk2(o.z, o.w) << 32);
                  *(unsigned long long*)(XB + (size_t)m * DM + c) = (unsigned long long)pk2(v.x, v.y) | ((unsigned long long)pk2(v.z, v.w) << 32); }
              ss += __shfl_xor(ss, 32); ss += __shfl_xor(ss, 16); ss += __shfl_xor(ss, 8); if (lane < 8) ssp[(size_t)m * 8 + lane] = ss; } }
    }
    GRID_BAR();

    }
#ifdef PROBE_XL
    if (XL_ON()) for (int i_ = 0; i_ < 1000; ++i_) __builtin_amdgcn_s_sleep(127);
#endif
    for (int hl = 0; hl < 2 * DEPTH; ++hl) {
        const int l = hl >> 1, mlp = hl & 1;
        {   const int N = mlp ? DFF : NIN; const bf16* Bt = (const bf16*)(WSP() + WS_W + (size_t)l * W_LAYER + (mlp ? W_UP : W_IN));
            pg8::Gemm g{P_XN(), Bt, M, N, DM}; pg8::StaticOrder S; S.init(M, N, G, CU_SLOT(), mlp ? 4 : 8);
            pg8::EpiBf16 E{mlp ? P_H() : P_QKV(), N, mlp, P_SSP(), P_BV(l, mlp), P_TAB(), (PG8_LAS float*)(ldsl + VEC_OFF)};
            pg8::gemm_phase<pg8::EpiBf16, pg8::StaticOrder, true, PG8_SP2>(ldsl + RING_OFF, g, S, E, wave);
        }
        SEAM_BAR(XL_ON());
        if (!mlp) {
            {   LAUNDER_LANE();
                bf16* QKV = P_QKV(); const float* ROPE_C = P_ROPE(); const float* ROPE_S = ROPE_C + 256 * 32; const float* kn = KIN(9) + l * 128;
                const int l32 = lane & 31, seg = l32 >> 3; const f32x4 g = *(const f32x4*)(kn + 4 * l32);
                constexpr int T2U = 4;
                const int vcuT = XL_ON() ? (int)bar.x * 32 + XL_RANK() : vcu; const int rowT = (vcuT >> 5) * 4096 + (vcuT & 31) * 8 + wave;
#define DPPF(v, ctrl) __builtin_bit_cast(float, __builtin_amdgcn_mov_dpp(__builtin_bit_cast(int, (v)), (ctrl), 0xF, 0xF, true))
                for (int k0 = 0; k0 < 16; k0 += T2U) {
                    unsigned long long w[T2U]; f32x4 cs[T2U], sn[T2U];
#pragma unroll
                    for (int u = 0; u < T2U; ++u) { const int m = rowT + 256 * (k0 + u), s = seq_of_row(m), t = m - seq_start(s), pos = seg < 2 ? (t >> 6) : (t & 63);
                        w[u] = *(const unsigned long long*)(QKV + (size_t)m * NIN + 1024 + (lane >> 5) * 128 + 4 * l32);
                        cs[u] = *(const f32x4*)(ROPE_C + pos * 32 + 4 * (l32 & 7)); sn[u] = *(const f32x4*)(ROPE_S + pos * 32 + 4 * (l32 & 7)); }
#pragma unroll
                    for (int u = 0; u < T2U; ++u) { const int m = rowT + 256 * (k0 + u); bf16* p = QKV + (size_t)m * NIN + 1024 + (lane >> 5) * 128 + 4 * l32;
                        const unsigned wlo = (unsigned)w[u], whi = (unsigned)(w[u] >> 32);
                        f32x4 v = {bf_lo(wlo), bf_hi(wlo), bf_lo(whi), bf_hi(whi)};
                        float ss = (v.x * v.x + v.y * v.y) + (v.z * v.z + v.w * v.w);
                        ss += DPPF(ss, 0xB1); ss += DPPF(ss, 0x4E); ss += DPPF(ss, 0x141); ss += DPPF(ss, 0x140);
                        { auto r_ = __builtin_amdgcn_permlane16_swap(__float_as_uint(ss), __float_as_uint(ss), false, false); ss = __uint_as_float(r_[0]) + __uint_as_float(r_[1]); }
                        v = v * __builtin_amdgcn_rsqf(ss * (1.f / 128.f) + EPS) * g;
                        f32x4 pn; pn.x = __shfl_xor(v.x, 8); pn.y = __shfl_xor(v.y, 8); pn.z = __shfl_xor(v.z, 8); pn.w = __shfl_xor(v.w, 8);
                        const f32x4 o = (seg & 1) ? v * cs[u] + pn * sn[u] : v * cs[u] - pn * sn[u];
                        *(unsigned long long*)p = (unsigned long long)pk2(o.x, o.y) | ((unsigned long long)pk2(o.z, o.w) << 32); } }
#undef DPPF
            }
            GRID_BAR();
            {   const int vcu2 = XL_ON() ? (int)bar.x * 32 + XL_RANK() : vcu; const int x = vcu2 >> 5, c32 = vcu2 & 31;
                const att::bf16* QKV = (const att::bf16*)P_QKV(); att::bf16* OB = (att::bf16*)P_O(); float* sso = P_SSOP();
                const float* qg = KIN(8) + l * 128; const float* rope = P_ROPE();
                float sbound;
                { const int ln = lane_now(); const float* kn = KIN(9) + l * 128; float gk = fmaxf(fabsf(kn[ln]), fabsf(kn[64 + ln])), gq = fmaxf(fabsf(qg[ln]), fabsf(qg[64 + ln]));
#pragma unroll
                  for (int of = 1; of < 64; of <<= 1) { gk = fmaxf(gk, __shfl_xor(gk, of)); gq = fmaxf(gq, __shfl_xor(gq, of)); }
                  sbound = 128.f * 1.03f * att::SCALE * att::LOG2E * __builtin_amdgcn_readfirstlane(gk) * __builtin_amdgcn_readfirstlane(gq); }
                const bool bounded = sbound <= 40.f;
                if (bounded) {
                for (int i = 0; i < 4; ++i) {
                    int h, qb, kvh, seq; size_t r0;
                    if (i < 2) { h = x; qb = c32 * 2 + i; kvh = h >> 2; seq = T0; r0 = 0; }
                    else { const int combo = x >> 1, s = 1 + (combo >> 1), ui = ((x & 1) * 32 + c32) * 2 + (i - 2); kvh = combo & 1; h = kvh * 4 + (ui >> 5); qb = ui & 31; seq = T1; r0 = (size_t)seq_start(s); }
                    att::attn_body<false, false>(QKV + (r0 + qb * 256) * NIN + h * 128, QKV + r0 * NIN + 1024 + kvh * 128, QKV + r0 * NIN + 1280 + kvh * 128,
                                          OB + (r0 + qb * 256) * DM + h * 128, seq, qb * 256, nullptr, 0.f, (att::lds_ptr)ldsl, (float*)(lds + AWS_OFF), qg, rope, sso + 16 * (r0 + qb * 256) + h, wave, sbound); }
                }
                if (!bounded) {
                for (int i = 0; i < 4; ++i) {
                    int h, qb, kvh, seq; size_t r0;
                    if (i < 2) { h = x; qb = c32 * 2 + i; kvh = h >> 2; seq = T0; r0 = 0; }
                    else { const int combo = x >> 1, s = 1 + (combo >> 1), ui = ((x & 1) * 32 + c32) * 2 + (i - 2); kvh = combo & 1; h = kvh * 4 + (ui >> 5); qb = ui & 31; seq = T1; r0 = (size_t)seq_start(s); }
                    att::attn_body<false, true>(QKV + (r0 + qb * 256) * NIN + h * 128, QKV + r0 * NIN + 1024 + kvh * 128, QKV + r0 * NIN + 1280 + kvh * 128,
                                          OB + (r0 + qb * 256) * DM + h * 128, seq, qb * 256, nullptr, 0.f, (att::lds_ptr)ldsl, (float*)(lds + AWS_OFF), qg, rope, sso + 16 * (r0 + qb * 256) + h, wave, 0.f); }
                }
                for (;;) {
                    __syncthreads();
                    if (wave == 0 && lane_now() == 0) MISC[13] = xb_add((unsigned*)((gu32*)(WSP() + WS_CTL) + CW_WQ + 64 * l), 1u);
                    __syncthreads();
                    const int t = lds_word_now<MISC_OFF + 52>();
                    if (t >= 1024) break;
                    const int h = 2 * (t & 3), rb = t >> 2, kvh = h >> 2, s = rb < 128 ? 0 : (rb < 192 ? 1 : 2); const size_t r0 = (size_t)seq_start(s);
                    const float* lut = (const float*)(lds + LUT_OFF) + h * LUT_STRIDE; const float sink2 = KIN(10)[l * 8 + h + (wave >> 2)] * LOG2E;
                    att::attn_body<true, true>(QKV + (size_t)(rb * 128) * NIN + 1536 + h * 128, QKV + r0 * NIN + 2560 + kvh * 128, QKV + r0 * NIN + 2816 + kvh * 128,
                                         OB + (size_t)(rb * 128) * DM + 1024 + h * 128, s == 0 ? T0 : T1, rb * 128 - (int)r0, lut, sink2, (att::lds_ptr)ldsl, (float*)(lds + AWS_OFF), nullptr, nullptr, sso + 16 * (size_t)(rb * 128) + 8 + h, wave, 0.f); }
            }
            GRID_BAR();
        }
        {   const int K = mlp ? DFF : DM; const bf16* Bt = (const bf16*)(WSP() + WS_W + (size_t)l * W_LAYER + (mlp ? W_DOWN : W_OUT));
            pg8::Gemm g{mlp ? P_H() : P_O(), Bt, M, DM, K}; pg8::StaticOrder S; S.init(M, DM, G, CU_SLOT(), 4, true);
            const bool nxt = hl + 1 < 2 * DEPTH;
            pg8::EpiRes E{P_XB(), P_MOD() + (size_t)l * 3 * MODW + (mlp ? 5 * DM : 2 * DM), mlp ? nullptr : P_SSOP(), nxt ? P_GV(hl + 1) : nullptr, P_XN(), P_SSP(), P_TAB(), (PG8_LAS float*)(ldsl + AWS_OFF), (PG8_LAS float*)(ldsl + VEC_OFF)};
            pg8::gemm_phase<pg8::EpiRes, pg8::StaticOrder, true, PG8_SP2>(ldsl + RING_OFF, g, S, E, wave);
        }
        SEAM_BAR(XL_ON() && hl + 1 < 2 * DEPTH);
    }
    {   LAUNDER_LANE(); float* outp = OUTP(); const float* gf = KIN(18); const bf16* XB = P_XB();
        for (int m0 = gw; m0 < M; m0 += 2 * NGW) {
            v4u w[2][4];
#pragma unroll
            for (int u = 0; u < 2; ++u)
#pragma unroll
                for (int j = 0; j < 4; ++j) w[u][j] = *(const v4u*)(XB + (size_t)(m0 + u * NGW) * DM + 8 * lane + 512 * j);
#pragma unroll
            for (int u = 0; u < 2; ++u) { const int m = m0 + u * NGW; float ss = 0.f;
#pragma unroll
                for (int j = 0; j < 4; ++j)
#pragma unroll
                    for (int e = 0; e < 4; ++e) { const float a = bf_lo(w[u][j][e]), b = bf_hi(w[u][j][e]); ss += a * a + b * b; }
                const float rinv = __builtin_amdgcn_rsqf(wave_sum(ss) * (1.f / DM) + EPS);
#pragma unroll
                for (int j = 0; j < 4; ++j) { const int c = 8 * lane + 512 * j; const f32x4 g0 = *(const f32x4*)(gf + c), g1 = *(const f32x4*)(gf + c + 4); f32x4 o0, o1;
                    o0.x = bf_lo(w[u][j].x) * rinv * g0.x; o0.y = bf_hi(w[u][j].x) * rinv * g0.y; o0.z = bf_lo(w[u][j].y) * rinv * g0.z; o0.w = bf_hi(w[u][j].y) * rinv * g0.w;
                    o1.x = bf_lo(w[u][j].z) * rinv * g1.x; o1.y = bf_hi(w[u][j].z) * rinv * g1.y; o1.z = bf_lo(w[u][j].w) * rinv * g1.z; o1.w = bf_hi(w[u][j].w) * rinv * g1.w;
                    *(f32x4*)(outp + (size_t)m * DM + c) = o0; *(f32x4*)(outp + (size_t)m * DM + c + 4) = o1; } }
        }
    }
#undef GRID_BAR
}

extern "C" void kernel_launch(void* const* d_in, const int* in_sizes, int n_in, void* d_out, int out_size, void* d_ws, size_t ws_size, hipStream_t stream) {
    static int grid = 0;
    if (grid == 0) {
        if (n_in != 19 || in_sizes[0] != T0 * DM || out_size != M * DM || ws_size < WS_END) { fprintf(stderr, "kernel_launch: shape mismatch (n_in %d, in0 %d, out %d, ws %zu need %zu)\n", n_in, n_in > 0 ? in_sizes[0] : -1, out_size, ws_size, (size_t)WS_END); grid = -1; return; }
        int dev = 0, cus = 0;
        if (hipGetDevice(&dev) != hipSuccess || hipDeviceGetAttribute(&cus, hipDeviceAttributeMultiprocessorCount, dev) != hipSuccess) { grid = -1; return; }
        if (hipFuncSetAttribute((const void*)fwd_kernel, hipFuncAttributeMaxDynamicSharedMemorySize, LDS_BYTES) != hipSuccess) { fprintf(stderr, "kernel_launch: hipFuncSetAttribute failed\n"); grid = -1; return; }
        (void)hipGetLastError();
        grid = cus;
        if (grid != 256) fprintf(stderr, "kernel_launch: %d CUs; the attention dealing assumes 256\n", grid);
    }
    if (grid < 0) return;
    if (hipMemsetAsync((char*)d_ws + WS_CTL, 0, CTL_ZERO_BYTES, stream) != hipSuccess) return;
    Args a{};
    for (int i = 0; i < 19; ++i) a.in[i] = (const float*)d_in[i];
    a.out = (float*)d_out; a.ws = (unsigned char*)d_ws;
    hipLaunchKernelGGL(fwd_kernel, dim3(grid), dim3(NWAVES * 64), LDS_BYTES, stream, a);
    const hipError_t le = hipPeekAtLastError();
    if (le != hipSuccess) fprintf(stderr, "kernel_launch: launch failed: %s\n", hipGetErrorName(le));
}
```
